# Optimizing an MI355X kernel written in HIP

```python
import jax, jax.numpy as jnp
from jax import lax
import numpy as np

D_MODEL = 2048
BATCH = 4
SEQ = 4096
DEPTH = 1
DEC_BATCH = 16
DEC_SEQ = 32
PAST_LEN = 1024

CHUNK = 64
MEM_LEN = 256
RET_HEADS = 8
RET_HEAD_DIM = 128
RET_WIDTH = RET_HEADS * RET_HEAD_DIM
GMLP_GROUPS = 4
GMLP_GROUP_DIM = 128
GMLP_WIDTH = GMLP_GROUPS * GMLP_GROUP_DIM
GMLP_CHUNK = 128
XA_HEADS = 4
XA_HEAD_DIM = 128
XA_WIDTH = XA_HEADS * XA_HEAD_DIM
MIX_WIDTH = RET_WIDTH + GMLP_WIDTH + XA_WIDTH
IN_WIDTH = 4 * RET_WIDTH + 3 * GMLP_WIDTH + 2 * XA_WIDTH
ROPE_BASE = 10000.0
EPS = 1e-6

kernel_name = "hybrid_retention_gmlp_memxattn_stream_step"


def rmsnorm(x, g):
    x32 = x.astype(jnp.float32)
    y = x32 * lax.rsqrt(jnp.mean(x32 * x32, axis=-1, keepdims=True) + EPS)
    return (y * g.astype(jnp.float32)).astype(x.dtype)


def layernorm(x, g):
    x32 = x.astype(jnp.float32)
    mu = jnp.mean(x32, axis=-1, keepdims=True)
    var = jnp.mean(jnp.square(x32 - mu), axis=-1, keepdims=True)
    return ((x32 - mu) * lax.rsqrt(var + EPS) * g.astype(jnp.float32)).astype(x.dtype)


def rope(x, pos):
    dh = x.shape[-1]
    inv_freq = ROPE_BASE ** (-jnp.arange(0, dh, 2, dtype=jnp.float32) / dh)
    ang = pos.astype(jnp.float32)[:, None] * inv_freq[None, :]
    cos = jnp.cos(ang)[None, :, None, :]
    sin = jnp.sin(ang)[None, :, None, :]
    x32 = x.astype(jnp.float32)
    x1, x2 = x32[..., : dh // 2], x32[..., dh // 2:]
    return jnp.concatenate([x1 * cos - x2 * sin, x1 * sin + x2 * cos], axis=-1)


def retention_block(q, k, v, S0, log_gamma):
    L = q.shape[1]
    idx = jnp.arange(L, dtype=jnp.float32)
    diff = idx[:, None] - idx[None, :]
    causal = diff >= 0
    decay = jnp.where(causal[None], jnp.exp(log_gamma[:, None, None] * jnp.where(causal, diff, 0.0)[None]), 0.0)
    scores = jnp.einsum('bihd,bjhd->bhij', q, k) * decay[None]
    o_intra = jnp.einsum('bhij,bjhe->bihe', scores, v)
    q_decay = jnp.exp(log_gamma[None, :] * (idx[:, None] + 1.0))
    o_cross = jnp.einsum('bihd,bhde->bihe', q, S0) * q_decay[None, :, :, None]
    k_decay = jnp.exp(log_gamma[None, :] * (L - 1.0 - idx[:, None]))
    S_new = jnp.exp(log_gamma * L)[None, :, None, None] * S0 + jnp.einsum(
        'bjhd,bjhe->bhde', k * k_decay[None, :, :, None], v)
    return o_intra + o_cross, S_new


def retention_forward(q, k, v, S0, log_gamma):
    B, L, H, Dh = q.shape
    blk = CHUNK if L % CHUNK == 0 else L
    n = L // blk

    def to_blocks(t):
        return jnp.moveaxis(t.reshape(B, n, blk, H, t.shape[-1]), 1, 0)

    def step(S, qkv):
        qb, kb, vb = qkv
        o, S_next = retention_block(qb, kb, vb, S, log_gamma)
        return S_next, o

    S_final, o = lax.scan(step, S0.astype(jnp.float32), (to_blocks(q), to_blocks(k), to_blocks(v)))
    o = jnp.moveaxis(o, 0, 1).reshape(B, L, H, v.shape[-1])
    return o, S_final


def head_groupnorm(o, g):
    mu = jnp.mean(o, axis=-1, keepdims=True)
    var = jnp.mean(jnp.square(o - mu), axis=-1, keepdims=True)
    B, L, H, D = o.shape
    return ((o - mu) * lax.rsqrt(var + EPS)).reshape(B, L, H * D) * g.astype(jnp.float32)


def memory_kv(mem, g_mem, w_mem_kv):
    B, M, _ = mem.shape
    kv = rmsnorm(mem, g_mem) @ w_mem_kv
    mk, mv = jnp.split(kv, 2, axis=-1)
    return mk.reshape(B, M, XA_HEADS, XA_HEAD_DIM), mv.reshape(B, M, XA_HEADS, XA_HEAD_DIM)


def hybrid_layer(x, pos, S0, mem_k, mem_v, g_norm, w_in, g_ret, g_gmlp, w_s, b_s, w_out):
    B, L, _ = x.shape
    h = rmsnorm(x, g_norm)
    proj = h @ w_in
    cuts = [RET_WIDTH, 2 * RET_WIDTH, 3 * RET_WIDTH, 4 * RET_WIDTH,
            4 * RET_WIDTH + GMLP_WIDTH, 4 * RET_WIDTH + 2 * GMLP_WIDTH, 4 * RET_WIDTH + 3 * GMLP_WIDTH,
            4 * RET_WIDTH + 3 * GMLP_WIDTH + XA_WIDTH]
    rq, rk, rv, rg, gu, gv, gg, aq, ag = jnp.split(proj, cuts, axis=-1)

    rq = rope(rq.reshape(B, L, RET_HEADS, RET_HEAD_DIM), pos)
    rk = rope(rk.reshape(B, L, RET_HEADS, RET_HEAD_DIM), pos) * (RET_HEAD_DIM ** -0.5)
    rv = rv.reshape(B, L, RET_HEADS, RET_HEAD_DIM).astype(jnp.float32)
    log_gamma = jnp.log(1.0 - 2.0 ** (-5.0 - jnp.arange(RET_HEADS, dtype=jnp.float32)))
    ro, S_new = retention_forward(rq, rk, rv, S0, log_gamma)
    ro = head_groupnorm(ro, g_ret).astype(x.dtype) * jax.nn.silu(rg)

    gv_n = layernorm(gv, g_gmlp)
    blk = GMLP_CHUNK if L % GMLP_CHUNK == 0 else L
    n = L // blk
    vb = gv_n.reshape(B, n, blk, GMLP_GROUPS, GMLP_GROUP_DIM)
    w_mask = jnp.tril(w_s[:, :blk, :blk])
    s = jnp.einsum('gij,bnjgc->bnigc', w_mask, vb) + b_s[:, :blk].T[None, None, :, :, None]
    go = gu * s.reshape(B, L, GMLP_WIDTH) * jax.nn.silu(gg)

    aq = aq.reshape(B, L, XA_HEADS, XA_HEAD_DIM).astype(jnp.float32)
    sc = jnp.einsum('blhd,bmhd->bhlm', aq, mem_k.astype(jnp.float32)) * (XA_HEAD_DIM ** -0.5)
    p = jax.nn.softmax(sc, axis=-1)
    ao = jnp.einsum('bhlm,bmhd->blhd', p, mem_v.astype(jnp.float32)).reshape(B, L, XA_WIDTH)
    ao = ao.astype(x.dtype) * jax.nn.silu(ag)

    out = x + jnp.concatenate([ro, go, ao], axis=-1) @ w_out
    return out, S_new, gv_n


def setup_inputs(seed: int = 0) -> dict:
    key = jax.random.key(seed)
    ks = jax.random.split(key, 20)
    f32 = jnp.float32
    nrm = lambda k, shape, scale: jax.random.normal(k, shape, f32) * scale
    return {
        "x_prompt": nrm(ks[0], (BATCH, SEQ, D_MODEL), 1.0),
        "x_sample": nrm(ks[1], (DEC_BATCH, DEC_SEQ, D_MODEL), 1.0),
        "mem_prompt": nrm(ks[2], (BATCH, MEM_LEN, D_MODEL), 1.0),
        "state_ret": nrm(ks[3], (DEPTH, DEC_BATCH, RET_HEADS, RET_HEAD_DIM, RET_HEAD_DIM), 0.5),
        "cache_mem_k": nrm(ks[4], (DEPTH, DEC_BATCH, MEM_LEN, XA_HEADS, XA_HEAD_DIM), 1.0),
        "cache_mem_v": nrm(ks[5], (DEPTH, DEC_BATCH, MEM_LEN, XA_HEADS, XA_HEAD_DIM), 1.0),
        "g_norm": 1.0 + nrm(ks[6], (DEPTH, D_MODEL), 0.02),
        "w_in": nrm(ks[7], (DEPTH, D_MODEL, IN_WIDTH), D_MODEL ** -0.5),
        "g_ret": 1.0 + nrm(ks[8], (DEPTH, RET_WIDTH), 0.02),
        "g_gmlp": 1.0 + nrm(ks[9], (DEPTH, GMLP_WIDTH), 0.02),
        "w_s": nrm(ks[10], (DEPTH, GMLP_GROUPS, GMLP_CHUNK, GMLP_CHUNK), GMLP_CHUNK ** -0.5),
        "b_s": 1.0 + nrm(ks[11], (DEPTH, GMLP_GROUPS, GMLP_CHUNK), 0.02),
        "g_mem": 1.0 + nrm(ks[12], (DEPTH, D_MODEL), 0.02),
        "w_mem_kv": nrm(ks[13], (DEPTH, D_MODEL, 2 * XA_WIDTH), D_MODEL ** -0.5),
        "w_out": nrm(ks[14], (DEPTH, MIX_WIDTH, D_MODEL), MIX_WIDTH ** -0.5),
        "g_final": 1.0 + nrm(ks[15], (D_MODEL,), 0.02),
    }


def reference(x_prompt, x_sample, mem_prompt, state_ret, cache_mem_k, cache_mem_v,
              g_norm, w_in, g_ret, g_gmlp, w_s, b_s, g_mem, w_mem_kv, w_out, g_final):
    b_p, l_p, _ = x_prompt.shape
    l_s = x_sample.shape[1]
    pos_p = jnp.arange(l_p, dtype=jnp.int32)
    pos_s = PAST_LEN + jnp.arange(l_s, dtype=jnp.int32)
    hp, hs = x_prompt, x_sample
    sp_list, mk_list, mv_list, ss_list, vs_list = [], [], [], [], []
    for l in range(DEPTH):
        mk, mv = memory_kv(mem_prompt, g_mem[l], w_mem_kv[l])
        S0p = jnp.zeros((b_p, RET_HEADS, RET_HEAD_DIM, RET_HEAD_DIM), jnp.float32)
        hp, Sp, _ = hybrid_layer(hp, pos_p, S0p, mk, mv, g_norm[l], w_in[l], g_ret[l],
                                 g_gmlp[l], w_s[l], b_s[l], w_out[l])
        hs, Ss, vs = hybrid_layer(hs, pos_s, state_ret[l], cache_mem_k[l], cache_mem_v[l],
                                  g_norm[l], w_in[l], g_ret[l], g_gmlp[l], w_s[l], b_s[l], w_out[l])
        sp_list.append(Sp)
        mk_list.append(mk)
        mv_list.append(mv)
        ss_list.append(Ss)
        vs_list.append(vs)
    y_prompt = rmsnorm(hp, g_final)
    y_sample = rmsnorm(hs, g_final)
    return (y_prompt, y_sample, jnp.stack(sp_list), jnp.stack(mk_list), jnp.stack(mv_list),
            jnp.stack(ss_list), jnp.stack(vs_list))
```

```cpp
#include <hip/hip_runtime.h>
#include <cstdio>
#include <cstdint>
namespace pg8 {
#define PG8_LAS __attribute__((address_space(3)))
typedef unsigned short bf16_t;
typedef short bf16x8 __attribute__((ext_vector_type(8)));
typedef float f32x4 __attribute__((ext_vector_type(4)));
typedef unsigned u32x4 __attribute__((ext_vector_type(4)));
constexpr int BM = 256, BK = 64, HALF = 128, HTB = HALF * BK * 2  , STAGE_BYTES = 8 * HTB, NXCD = 8, WGM = 8;

__host__ __device__ __forceinline__ int lds_byte(int r, int c) { const int st = (r >> 4) * 2 + (c >> 5), rr = r & 15, cc = c & 31, ob = rr * 64 + cc * 2; return st * 1024 + (ob ^ (((ob >> 9) & 1) << 5)); }
__host__ __device__ __forceinline__ void stage_rc(int b, int& R, int& C) { const int st = b / 1024, sb = b % 1024, swz = sb ^ (((sb >> 9) & 1) << 5); R = (st >> 1) * 16 + swz / 64; C = (st & 1) * 32 + (swz % 64) / 2; }
__host__ __device__ __forceinline__ int perm32(int rho) { const int n = rho >> 4, i = rho & 15; return 8 * (i >> 2) + 4 * n + (i & 3); }

struct Unit { int pm, pn; };
struct Gemm { const bf16_t* A; const bf16_t* Bt; int M, N, K; };

struct StaticOrder {
    int nM, nN, nwg, G, c;
    __host__ __device__ void init(int M, int N, int G_, int c_) { nM = M / BM; nN = N / BM; nwg = nM * nN; G = G_; c = c_; }
    __host__ __device__ bool next(int i, Unit& u) const {
        const long L = (long)i * G + c; if (L >= nwg) return false;
        int wgid = (int)L; { const int q = nwg / NXCD, r = nwg % NXCD, xcd = wgid % NXCD, off = wgid / NXCD; wgid = (xcd < r ? xcd * (q + 1) : r * (q + 1) + (xcd - r) * q) + off; }
        const int nig = WGM * nN, gid = wgid / nig, fm = gid * WGM, gsz = (nM - fm) < WGM ? (nM - fm) : WGM;
        u.pm = fm + ((wgid % nig) % gsz); u.pn = (wgid % nig) / gsz; return true;
    }
    __device__ __forceinline__ void a_ready(const Unit&) const {}
    __device__ __forceinline__ void done(const Unit&) const {}
};
__device__ __forceinline__ unsigned cvt_pk_bf16(float lo, float hi) { unsigned r; asm volatile("v_cvt_pk_bf16_f32 %0, %1, %2" : "=v"(r) : "v"(lo), "v"(hi)); return r; }
typedef float f32x2 __attribute__((ext_vector_type(2)));

struct Order1 {
    StaticOrder so; int G, c;
    __device__ void init(int G_, int c_) { so.init(16896, 6656, G_, c_); G = G_; c = c_; }
    __device__ bool next(int i, Unit& u) const {
        if (so.next(i, u)) return true;
        const long L = (long)i * G + c - so.nwg; if (L < 0 || L >= 16) return false;
        u.pm = 66 + (int)(L >> 2); u.pn = 26 + (int)(L & 3); return true;
    }
    __device__ __forceinline__ void a_ready(const Unit&) const {}
    __device__ __forceinline__ void done(const Unit&) const {}
};
struct EpiProj {
    static constexpr bool PERM = true, AFTER_DRAIN = false;
    bf16_t* proj; float* out_mk; float* out_mv; bf16_t* mkv;
    __device__ __forceinline__ void operator()(const f32x4 (&acc)[2][2][4][2], const Unit& u, int wr, int wc, int fr, int fq) const {
        if (u.pm < 66) {
            const int row0 = u.pm * BM + wr * 64 + fr, col0 = u.pn * BM + wc * 32 + 8 * fq;
#pragma unroll
            for (int ai = 0; ai < 2; ++ai)
#pragma unroll
                for (int m = 0; m < 4; ++m) { bf16_t* rowp = proj + (size_t)(row0 + ai * HALF + m * 16) * 6656 + col0;
#pragma unroll
                    for (int bj = 0; bj < 2; ++bj) { const f32x4 v0 = acc[ai][bj][m][0], v1 = acc[ai][bj][m][1];
                        u32x4 w; w.x = cvt_pk_bf16(v0[0], v0[1]); w.y = cvt_pk_bf16(v0[2], v0[3]); w.z = cvt_pk_bf16(v1[0], v1[1]); w.w = cvt_pk_bf16(v1[2], v1[3]);
                        *(u32x4*)(rowp + bj * HALF) = w; } }
        } else {
            const int row0 = (u.pm - 66) * BM + wr * 64 + fr, col0 = (u.pn - 26) * BM + wc * 32 + 8 * fq;
            float* const dst0 = (u.pn - 26) < 2 ? out_mk : out_mv; const int cbase = col0 & 511;
#pragma unroll
            for (int ai = 0; ai < 2; ++ai)
#pragma unroll
                for (int m = 0; m < 4; ++m) { const int row = row0 + ai * HALF + m * 16;
#pragma unroll
                    for (int bj = 0; bj < 2; ++bj) { const f32x4 v0 = acc[ai][bj][m][0], v1 = acc[ai][bj][m][1];
                        float* d = dst0 + (size_t)row * 512 + cbase + bj * HALF; *(f32x4*)d = v0; *(f32x4*)(d + 4) = v1;
                        u32x4 w; w.x = cvt_pk_bf16(v0[0], v0[1]); w.y = cvt_pk_bf16(v0[2], v0[3]); w.z = cvt_pk_bf16(v1[0], v1[1]); w.w = cvt_pk_bf16(v1[2], v1[3]);
                        *(u32x4*)(mkv + (size_t)row * 1024 + col0 + bj * HALF) = w; } }
        }
    }
};
struct EpiOut {
    static constexpr bool PERM = false, AFTER_DRAIN = false;
    const float* xp; const float* xs; float* out; float* ssq;
    __device__ __forceinline__ void operator()(const f32x4 (&acc)[2][2][4][2], const Unit& u, int wr, int wc, int fr, int fq) const {
        const int col0 = u.pn * BM + wc * 32 + 4 * fq;
#pragma unroll
        for (int ai = 0; ai < 2; ++ai)
#pragma unroll
            for (int m = 0; m < 4; ++m) { const int row = u.pm * BM + ai * HALF + wr * 64 + m * 16 + fr;
                const float* xrow = row < 16384 ? xp + (size_t)row * 2048 : xs + (size_t)(row - 16384) * 2048; float* orow = out + (size_t)row * 2048; float s = 0.f;
#pragma unroll
                for (int bj = 0; bj < 2; ++bj)
#pragma unroll
                    for (int n = 0; n < 2; ++n) { const int c = col0 + bj * HALF + n * 16; const f32x4 o = *(const f32x4*)(xrow + c) + acc[ai][bj][m][n]; *(f32x4*)(orow + c) = o;
                        s += (o[0] * o[0] + o[1] * o[1]) + (o[2] * o[2] + o[3] * o[3]); }
                s += __shfl_xor(s, 16); s += __shfl_xor(s, 32);
                if (fq == 0) ssq[(size_t)row * 32 + u.pn * 4 + wc] = s;
                if (m & 1) asm volatile("" ::: "memory"); }
    }
};
template <class Epi, class Sched, bool ALIGN_EPI = false, bool SP2 = false>
__device__ __forceinline__ void gemm_phase(PG8_LAS unsigned char* lds, const Gemm g, const Sched& S, const Epi& E) {
    int tid_ = threadIdx.x; asm volatile("" : "+v"(tid_));
    const int tid = tid_, wid = __builtin_amdgcn_readfirstlane(tid >> 6), lane = tid & 63, wr = wid >> 2, wc = wid & 3, fr = lane & 15, fq = lane >> 4;
    const int K = g.K, nt = K / BK;
    unsigned voffA[2], voffB[2];
#pragma unroll
    for (int i = 0; i < 2; ++i) { int R, C; stage_rc(tid * 16 + i * 8192, R, C); const int Rb = Epi::PERM ? ((R & ~31) + perm32(R & 31)) : R;
        voffA[i] = (unsigned)(R * K + C) * 2u; voffB[i] = (unsigned)(Rb * K + C) * 2u; }
    const size_t kstep = (size_t)(BK * 2);
    const size_t hstep = (size_t)HALF * K * 2;
    const size_t tstep = 2 * hstep;
    const unsigned ldsw = (unsigned)wid * 1024u;
    const int aoff = lds_byte(wr * 64 + fr, fq * 8), boff = lds_byte(wc * 32 + fr, fq * 8);
#define PG8_SA(b, h) (((b) * 2 + (h)) * HTB)
#define PG8_SB(b, h) ((4 + (b) * 2 + (h)) * HTB)
#define PG8_STAGE(bufoff, gbase, voff) do { _Pragma("unroll") for (int _i = 0; _i < 2; ++_i) \
        __builtin_amdgcn_global_load_lds((const unsigned*)((const char*)(gbase) + (voff)[_i]), (PG8_LAS unsigned*)(lds + (bufoff) + ldsw + _i * 8192), 16, 0, 0); } while (0)
#define PG8_LDA(dst, b, h) do { _Pragma("unroll") for (int m = 0; m < 4; ++m) _Pragma("unroll") for (int k = 0; k < 2; ++k) dst[m][k] = *(const PG8_LAS bf16x8*)(lds + PG8_SA(b, h) + aoff + m * 2048 + k * 1024); } while (0)
#define PG8_LDB(dst, b, h) do { _Pragma("unroll") for (int n = 0; n < 2; ++n) _Pragma("unroll") for (int k = 0; k < 2; ++k) dst[n][k] = *(const PG8_LAS bf16x8*)(lds + PG8_SB(b, h) + boff + n * 2048 + k * 1024); } while (0)
#define PG8_MMA(ai, bj, At, Bt) do { __builtin_amdgcn_s_setprio(1); _Pragma("unroll") for (int m = 0; m < 4; ++m) _Pragma("unroll") for (int n = 0; n < 2; ++n) _Pragma("unroll") for (int k = 0; k < 2; ++k) \
        acc[ai][bj][m][n] = __builtin_amdgcn_mfma_f32_16x16x32_bf16(Bt[n][k], At[m][k], acc[ai][bj][m][n], 0, 0, 0); __builtin_amdgcn_s_setprio(0); } while (0)
#define PG8_WAIT_V(n) asm volatile("s_waitcnt vmcnt(" #n ")" ::: "memory")
#define PG8_WAIT_L(n) asm volatile("s_waitcnt lgkmcnt(" #n ")" ::: "memory")
#define PG8_BAR __builtin_amdgcn_s_barrier()
#define PG8_SCHED __builtin_amdgcn_sched_barrier(0)
    Unit cur, nxt; int ui = 0;
    if (!S.next(0, cur)) return;
    f32x4 acc[2][2][4][2];
#pragma unroll
    for (int a = 0; a < 2; ++a)
#pragma unroll
        for (int b = 0; b < 2; ++b)
#pragma unroll
            for (int m = 0; m < 4; ++m)
#pragma unroll
                for (int n = 0; n < 2; ++n) acc[a][b][m][n] = (f32x4){0.f, 0.f, 0.f, 0.f};
    bf16x8 At[4][2], B0[2][2], B1[2][2];
    const char* cA = (const char*)g.A + (size_t)cur.pm * tstep; const char* cB = (const char*)g.Bt + (size_t)cur.pn * tstep;
    S.a_ready(cur);
    if constexpr (SP2) {
        PG8_STAGE(PG8_SB(0, 0), cB, voffB); PG8_STAGE(PG8_SB(0, 1), cB + hstep, voffB); PG8_STAGE(PG8_SA(0, 0), cA, voffA); PG8_STAGE(PG8_SA(0, 1), cA + hstep, voffA);
        if (wr == 1) PG8_BAR;
        PG8_WAIT_V(2); PG8_BAR;
        PG8_STAGE(PG8_SB(1, 0), cB + kstep, voffB); PG8_STAGE(PG8_SA(1, 0), cA + kstep, voffA); PG8_STAGE(PG8_SB(1, 1), cB + hstep + kstep, voffB);
        PG8_WAIT_V(6); PG8_BAR;
    } else {
        PG8_STAGE(PG8_SB(0, 0), cB, voffB); PG8_STAGE(PG8_SA(0, 0), cA, voffA); PG8_STAGE(PG8_SB(0, 1), cB + hstep, voffB); PG8_STAGE(PG8_SA(0, 1), cA + hstep, voffA);
        if (wr == 1) PG8_BAR;
        PG8_WAIT_V(4); PG8_BAR;
        PG8_STAGE(PG8_SB(1, 0), cB + kstep, voffB); PG8_STAGE(PG8_SA(1, 0), cA + kstep, voffA); PG8_STAGE(PG8_SB(1, 1), cB + hstep + kstep, voffB);
        PG8_WAIT_V(6); PG8_BAR;
    }
    for (;;) {
        const bool has_next = S.next(ui + 1, nxt);
        const char* nA = has_next ? (const char*)g.A + (size_t)nxt.pm * tstep : cA; const char* nB = has_next ? (const char*)g.Bt + (size_t)nxt.pn * tstep : cB;
        for (int t = 0; t < nt; t += 2) {
            const bool last = (t == nt - 2);
            const char* a1 = cA + (size_t)(t + 1) * kstep;
            const char* a2 = last ? nA : cA + (size_t)(t + 2) * kstep; const char* b2 = last ? nB : cB + (size_t)(t + 2) * kstep;
            const char* a3 = a2 + kstep; const char* b3 = b2 + kstep;
            if (last && has_next) S.a_ready(nxt);
            if constexpr (SP2) {
            PG8_LDB(B0, 0, 0); PG8_LDB(B1, 0, 1); PG8_SCHED; PG8_LDA(At, 0, 0); PG8_STAGE(PG8_SA(1, 1), a1 + hstep, voffA);
            PG8_WAIT_V(8); PG8_WAIT_L(0); PG8_BAR; PG8_MMA(0, 0, At, B0); PG8_MMA(0, 1, At, B1); PG8_BAR; PG8_SCHED;
            PG8_LDA(At, 0, 1); PG8_STAGE(PG8_SB(0, 0), b2, voffB); PG8_STAGE(PG8_SB(0, 1), b2 + hstep, voffB); PG8_STAGE(PG8_SA(0, 0), a2, voffA);
            PG8_WAIT_V(8); PG8_WAIT_L(0); PG8_BAR; PG8_MMA(1, 0, At, B0); PG8_MMA(1, 1, At, B1); PG8_BAR; PG8_SCHED;
            PG8_LDB(B0, 1, 0); PG8_LDB(B1, 1, 1); PG8_SCHED; PG8_LDA(At, 1, 0); PG8_STAGE(PG8_SA(0, 1), a2 + hstep, voffA);
            PG8_WAIT_V(8); PG8_WAIT_L(0); PG8_BAR; PG8_MMA(0, 0, At, B0); PG8_MMA(0, 1, At, B1); PG8_BAR; PG8_SCHED;
            PG8_LDA(At, 1, 1); PG8_STAGE(PG8_SB(1, 0), b3, voffB); PG8_STAGE(PG8_SB(1, 1), b3 + hstep, voffB); PG8_STAGE(PG8_SA(1, 0), a3, voffA);
            PG8_WAIT_V(8); PG8_WAIT_L(0); PG8_BAR; PG8_MMA(1, 0, At, B0); PG8_MMA(1, 1, At, B1); PG8_BAR; PG8_SCHED;
            } else {
            PG8_LDB(B0, 0, 0); PG8_SCHED; PG8_LDA(At, 0, 0); PG8_STAGE(PG8_SA(1, 1), a1 + hstep, voffA);
            PG8_WAIT_L(8); PG8_BAR; PG8_WAIT_L(0); PG8_MMA(0, 0, At, B0); PG8_BAR; PG8_SCHED;
            PG8_LDB(B1, 0, 1); PG8_STAGE(PG8_SB(0, 0), b2, voffB);
            PG8_BAR; PG8_WAIT_L(0); PG8_MMA(0, 1, At, B1); PG8_BAR;
            PG8_LDA(At, 0, 1); PG8_STAGE(PG8_SA(0, 0), a2, voffA);
            PG8_BAR; PG8_WAIT_L(0); PG8_MMA(1, 0, At, B0); PG8_BAR; PG8_SCHED;
            PG8_STAGE(PG8_SB(0, 1), b2 + hstep, voffB);
            PG8_WAIT_V(6); PG8_BAR; PG8_MMA(1, 1, At, B1); PG8_BAR;
            PG8_LDB(B0, 1, 0); PG8_SCHED; PG8_LDA(At, 1, 0); PG8_STAGE(PG8_SA(0, 1), a2 + hstep, voffA);
            PG8_WAIT_L(8); PG8_BAR; PG8_WAIT_L(0); PG8_MMA(0, 0, At, B0); PG8_BAR; PG8_SCHED;
            PG8_LDB(B1, 1, 1); PG8_STAGE(PG8_SB(1, 0), b3, voffB);
            PG8_BAR; PG8_WAIT_L(0); PG8_MMA(0, 1, At, B1); PG8_BAR;
            PG8_LDA(At, 1, 1); PG8_STAGE(PG8_SA(1, 0), a3, voffA);
            PG8_BAR; PG8_WAIT_L(0); PG8_MMA(1, 0, At, B0); PG8_BAR; PG8_SCHED;
            PG8_STAGE(PG8_SB(1, 1), b3 + hstep, voffB);
            PG8_WAIT_V(6); PG8_BAR; PG8_MMA(1, 1, At, B1); PG8_BAR;
            }
        }
        if constexpr (ALIGN_EPI) { if (wr == 0) PG8_BAR; }
        if constexpr (!Epi::AFTER_DRAIN) { E(acc, cur, wr, wc, fr, fq); S.done(cur); }
        if (!has_next) break;
#pragma unroll
        for (int a = 0; a < 2; ++a)
#pragma unroll
            for (int b = 0; b < 2; ++b)
#pragma unroll
                for (int m = 0; m < 4; ++m)
#pragma unroll
                    for (int n = 0; n < 2; ++n) acc[a][b][m][n] = (f32x4){0.f, 0.f, 0.f, 0.f};
        cur = nxt; cA = nA; cB = nB; ++ui;
        if constexpr (ALIGN_EPI) { if (wr == 1) PG8_BAR; }
    }
    PG8_WAIT_V(0);
    if constexpr (!ALIGN_EPI) { if (wr == 0) PG8_BAR; }
    PG8_BAR;
    if constexpr (Epi::AFTER_DRAIN) { E.fused(acc, cur, wr, wc, fr, fq, lds, wid, lane); S.done(cur); }
#undef PG8_SA
#undef PG8_SB
#undef PG8_STAGE
#undef PG8_LDA
#undef PG8_LDB
#undef PG8_MMA
#undef PG8_WAIT_V
#undef PG8_WAIT_L
#undef PG8_BAR
#undef PG8_SCHED
}
}
#define GAS __attribute__((address_space(1)))
#define LAS __attribute__((address_space(3)))
typedef unsigned short bf16;
typedef unsigned v4u __attribute__((ext_vector_type(4)));
typedef float f32x4 __attribute__((ext_vector_type(4)));
typedef short bf16x8 __attribute__((ext_vector_type(8)));
typedef GAS unsigned gu32;
typedef GAS unsigned long long gu64;
#define RLX_AGENT __ATOMIC_RELAXED, __HIP_MEMORY_SCOPE_AGENT
#define LDS_WAIT() asm volatile("s_waitcnt lgkmcnt(0)" ::: "memory")
#define VM_WAIT() asm volatile("s_waitcnt vmcnt(0)" ::: "memory")
__device__ __forceinline__ unsigned long long rt() { return __builtin_amdgcn_s_memrealtime(); }
__device__ __forceinline__ unsigned f2bf(float f) { unsigned u = __builtin_bit_cast(unsigned, f); return (u + 0x7fffu + ((u >> 16) & 1u)) >> 16; }
__device__ __forceinline__ unsigned pk2(float lo, float hi) { return f2bf(lo) | (f2bf(hi) << 16); }

#define XB_TMO      128
#define XB_XCNT(j)  (256  + 64 * (j))
#define XB_XSUB(j)  (1280 + 64 * (j))
#define XB_XGEN(j)  (2304 + 64 * (j))
#define XB_TOP      3328
#define XB_TOPGEN   3392
#define XCD_BAR_WORDS 3456
#define XB_SPIN_CAP (1u << 18)

__device__ __forceinline__ unsigned xb_ld(unsigned* p)              { return __hip_atomic_load(p, __ATOMIC_RELAXED, __HIP_MEMORY_SCOPE_AGENT); }
__device__ __forceinline__ unsigned xb_add(unsigned* p, unsigned v) { return __hip_atomic_fetch_add(p, v, __ATOMIC_RELAXED, __HIP_MEMORY_SCOPE_AGENT); }
__device__ __forceinline__ unsigned xb_xcc_id() { return (unsigned)__builtin_amdgcn_s_getreg((3 << 11) | 20) & 0xFu; }
#define XB_SPIN(cond, bar) do { unsigned _sp = 0; while (cond) { __builtin_amdgcn_s_sleep(1); \
    if ((++_sp & 255u) == 0u) { if (xb_ld(&(bar)[XB_TMO])) break; if (_sp > XB_SPIN_CAP) { atomicAdd(&(bar)[XB_TMO], 1u); break; } } } } while (0)

struct XcdBarrier {
    unsigned* bar; unsigned x;
    volatile LAS unsigned* st;
};

__device__ __forceinline__ XcdBarrier xcd_barrier_post(unsigned* bar, volatile LAS unsigned* st) {
    XcdBarrier b; b.bar = bar; b.x = xb_xcc_id(); b.st = st;
    if (threadIdx.x == 0) (void)xb_add(&bar[XB_XCNT(b.x)], 1u);
    return b;
}
__device__ __forceinline__ void xcd_barrier_complete(unsigned* bar, unsigned x, unsigned& nloc, unsigned& nx) {
    const unsigned G = gridDim.x * gridDim.y * gridDim.z;
    unsigned sum, cnt, mine, sp = 0u;
    for (;;) {
        sum = 0u; cnt = 0u; mine = 0u;
#pragma unroll
        for (unsigned j = 0; j < 16; ++j) { const unsigned c = xb_ld(&bar[XB_XCNT(j)]); sum += c; cnt += (c > 0u) ? 1u : 0u; mine = (j == x) ? c : mine; }
        if (sum == G) break;
        __builtin_amdgcn_s_sleep(1);
        if ((++sp & 255u) == 0u) { if (xb_ld(&bar[XB_TMO])) break; if (sp > XB_SPIN_CAP) { atomicAdd(&bar[XB_TMO], 1u); break; } }
    }
    nloc = mine > 0u ? mine : 1u; nx = cnt > 0u ? cnt : 1u;
}

__device__ __forceinline__ void xcd_barrier(const XcdBarrier& b) {
    asm volatile("s_waitcnt vmcnt(0)" ::: "memory");
    __syncthreads();
    if (threadIdx.x == 0) {
        unsigned* bar = b.bar;
        __builtin_amdgcn_s_waitcnt(0);
        unsigned nloc = b.st[0], nx = b.st[1];
        if (nloc == 0u) { xcd_barrier_complete(bar, b.x, nloc, nx); b.st[0] = nloc; b.st[1] = nx; }
        const unsigned old = xb_add(&bar[XB_XSUB(b.x)], 1u);
        const unsigned gen = old / nloc;
        if (old + 1u == (gen + 1u) * nloc) {
            __builtin_amdgcn_fence(__ATOMIC_RELEASE, "agent");
            asm volatile("s_waitcnt vmcnt(0)" ::: "memory");
            const unsigned og = xb_add(&bar[XB_TOP], 1u);
            const unsigned tg = og / nx;
            if (og + 1u == (tg + 1u) * nx) xb_add(&bar[XB_TOPGEN], 1u);
            else XB_SPIN(xb_ld(&bar[XB_TOPGEN]) == tg, bar);
            __builtin_amdgcn_fence(__ATOMIC_ACQUIRE, "agent");
            xb_add(&bar[XB_XGEN(b.x)], 1u);
            asm volatile("s_waitcnt vmcnt(0)" ::: "memory");
        } else {
            XB_SPIN(xb_ld(&bar[XB_XGEN(b.x)]) == gen, bar);
            __builtin_amdgcn_fence(__ATOMIC_ACQUIRE, "agent");
            asm volatile("s_waitcnt vmcnt(0)" ::: "memory");
        }
    }
    __syncthreads();
}

constexpr int NWAVES = 8;
constexpr int DM = 2048, TP = 16384, TS = 512, MTOK = TP + TS, SEQ = 4096, NBATCH = 4, DECB = 16, DECL = 32, PAST = 1024, MEMLEN = 256, NMEM = NBATCH * MEMLEN;
constexpr int INW = 6656, KVW = 1024;
constexpr int C_RQ = 0, C_RK = 1024, C_RV = 2048, C_RG = 3072, C_GU = 4096, C_GV = 4608, C_GG = 5120, C_AQ = 5632, C_AG = 6144;
constexpr int MIXW = 2048, MX_RO = 0, MX_GO = 1024, MX_AO = 1536;
constexpr float EPS = 1e-6f;
constexpr size_t O_Y = 0, O_SRP = (size_t)MTOK * DM, O_MK = O_SRP + 4 * 8 * 128 * 128, O_MV = O_MK + (size_t)NMEM * 512, O_SRS = O_MV + (size_t)NMEM * 512,
                 O_GVS = O_SRS + (size_t)DECB * 8 * 128 * 128, O_END = O_GVS + (size_t)DECB * DECL * 512;
static_assert(O_END == 38535168, "d_out size");
constexpr size_t MiB = 1u << 20;
constexpr size_t WS_CTL = 0, CTL_ZERO_BYTES = 1 * MiB;
constexpr size_t WS_WINT = 2 * MiB;
constexpr size_t WS_WOUTT = 32 * MiB;
constexpr size_t WS_XN = 40 * MiB;
constexpr size_t WS_PROJ = 112 * MiB;
constexpr size_t WS_MIX = 328 * MiB;
constexpr size_t WS_MKV = 394 * MiB;
constexpr size_t WS_CK = 396 * MiB, WS_CV = 400 * MiB;
constexpr size_t WS_ROPE = 404 * MiB;
constexpr size_t WS_SSQ = 407 * MiB;
constexpr size_t WS_WTRIL = 410 * MiB;
constexpr size_t WS_END = 412 * MiB;
constexpr int CW_BAR = 4096;
constexpr int CW_Q = 64;
constexpr int RING_BYTES = 131072, LDSCTL_OFF = RING_BYTES, MISC_OFF = LDSCTL_OFF + 320, LDS_BYTES = 147456;

__device__ const float INV_FREQ[64] = {
1.000000000e+00f, 8.659643531e-01f, 7.498942018e-01f, 6.493816376e-01f, 5.623413324e-01f, 4.869675338e-01f, 4.216965139e-01f, 3.651741147e-01f,
3.162277639e-01f, 2.738419771e-01f, 2.371373773e-01f, 2.053525001e-01f, 1.778279394e-01f, 1.539926529e-01f, 1.333521456e-01f, 1.154781953e-01f,
1.000000015e-01f, 8.659642935e-02f, 7.498942316e-02f, 6.493816525e-02f, 5.623413250e-02f, 4.869675264e-02f, 4.216964915e-02f, 3.651741147e-02f,
3.162277490e-02f, 2.738419548e-02f, 2.371373773e-02f, 2.053525113e-02f, 1.778279431e-02f, 1.539926510e-02f, 1.333521400e-02f, 1.154781971e-02f,
9.999999776e-03f, 8.659643121e-03f, 7.498942316e-03f, 6.493816152e-03f, 5.623413250e-03f, 4.869675264e-03f, 4.216964822e-03f, 3.651741194e-03f,
3.162277630e-03f, 2.738419687e-03f, 2.371373819e-03f, 2.053525066e-03f, 1.778279431e-03f, 1.539926510e-03f, 1.333521446e-03f, 1.154782018e-03f,
1.000000047e-03f, 8.659643354e-04f, 7.498941850e-04f, 6.493816036e-04f, 5.623413017e-04f, 4.869675322e-04f, 4.216965172e-04f, 3.651741135e-04f,
3.162277571e-04f, 2.738419571e-04f, 2.371373703e-04f, 2.053525095e-04f, 1.778279402e-04f, 1.539926598e-04f, 1.333521504e-04f, 1.154782003e-04f
};

typedef short s16x4 __attribute__((ext_vector_type(4)));
typedef unsigned u32x2 __attribute__((ext_vector_type(2)));
typedef float f32x2 __attribute__((ext_vector_type(2)));
typedef __bf16 bf16x2_t __attribute__((ext_vector_type(2)));
typedef short v4i16_t __attribute__((ext_vector_type(4)));
__device__ __forceinline__ unsigned pkbf(float lo, float hi) { f32x2 v = {lo, hi}; bf16x2_t b = __builtin_convertvector(v, bf16x2_t); return __builtin_bit_cast(unsigned, b); }
__device__ __forceinline__ float bflo(unsigned w) { return __uint_as_float(w << 16); }
__device__ __forceinline__ float bfhi(unsigned w) { return __uint_as_float(w & 0xffff0000u); }
__device__ __forceinline__ float bfel(const v4u& x, int e) { const unsigned w = x[e >> 1]; return (e & 1) ? bfhi(w) : bflo(w); }
__device__ __forceinline__ float silu_f(float x) { return x * __builtin_amdgcn_rcpf(1.0f + __builtin_amdgcn_exp2f(-1.4426950408889634f * x)); }
__device__ __forceinline__ float wave_sum(float v) {
#pragma unroll
    for (int o = 1; o < 64; o <<= 1) v += __shfl_xor(v, o);
    return v;
}
__device__ __forceinline__ f32x4 mfma16(bf16x8 a, bf16x8 b, f32x4 c) { return __builtin_amdgcn_mfma_f32_16x16x32_bf16(a, b, c, 0, 0, 0); }
__device__ __forceinline__ s16x4 lds_tr(LAS unsigned char* p) { return __builtin_bit_cast(s16x4, __builtin_amdgcn_ds_read_tr16_b64_v4i16((LAS v4i16_t*)p)); }
__device__ __forceinline__ bf16x8 cat8(s16x4 lo, s16x4 hi) { return (bf16x8){lo[0], lo[1], lo[2], lo[3], hi[0], hi[1], hi[2], hi[3]}; }
__device__ __forceinline__ bf16x8 pack8(const f32x4& a, const f32x4& b) { v4u w; w.x = pkbf(a[0], a[1]); w.y = pkbf(a[2], a[3]); w.z = pkbf(b[0], b[1]); w.w = pkbf(b[2], b[3]); return __builtin_bit_cast(bf16x8, w); }

__device__ __forceinline__ void p0_transpose_item(const float* W, int K, int N, bf16* WT, int row_off, LAS float* scr, int item, int lane) {
    const int nblk = N / 32, kb = item / nblk, nb = item % nblk, k0 = 64 * kb, n0 = 32 * nb;
#pragma unroll 8
    for (int i = 0; i < 32; ++i) { const int kk = 2 * i + (lane >> 5); scr[kk * 33 + (lane & 31)] = W[(size_t)(k0 + kk) * N + n0 + (lane & 31)]; }
    LDS_WAIT(); asm volatile("" ::: "memory");
    const int c = lane & 7;
#pragma unroll
    for (int j = 0; j < 4; ++j) { const int n = (lane >> 3) + 8 * j; const LAS float* s = scr + (8 * c) * 33 + n;
        v4u o; o.x = pk2(s[0 * 33], s[1 * 33]); o.y = pk2(s[2 * 33], s[3 * 33]); o.z = pk2(s[4 * 33], s[5 * 33]); o.w = pk2(s[6 * 33], s[7 * 33]);
        *(GAS v4u*)(WT + (size_t)(row_off + n0 + n) * K + k0 + 8 * c) = o; }
    LDS_WAIT(); asm volatile("" ::: "memory");
}
__device__ __forceinline__ void rms_row_to_bf16(const float* xrow, const float* g, bf16* orow, int lane) {
    const GAS f32x4* xr = (const GAS f32x4*)xrow + lane; const GAS f32x4* gr = (const GAS f32x4*)g + lane;
    f32x4 v[8]; float s = 0.f;
#pragma unroll
    for (int j = 0; j < 8; ++j) { v[j] = xr[64 * j]; s += (v[j].x * v[j].x + v[j].y * v[j].y) + (v[j].z * v[j].z + v[j].w * v[j].w); }
    const float rstd = 1.f / sqrtf(wave_sum(s) * (1.f / DM) + EPS);
    GAS unsigned long long* o8 = (GAS unsigned long long*)orow + lane;
#pragma unroll
    for (int j = 0; j < 8; ++j) { const f32x4 gg = gr[64 * j];
        o8[64 * j] = (unsigned long long)pk2(v[j].x * rstd * gg.x, v[j].y * rstd * gg.y) | ((unsigned long long)pk2(v[j].z * rstd * gg.z, v[j].w * rstd * gg.w) << 32); }
}
struct Ptrs {
    const float *x_prompt, *x_sample, *mem_prompt, *state_ret, *cache_k, *cache_v, *g_norm, *w_in, *g_ret, *g_gmlp, *w_s, *b_s, *g_mem, *w_mem_kv, *w_out, *g_final;
    float* out; unsigned char* ws;
};
__device__ __forceinline__ void p0_prologue(const Ptrs& P, LAS unsigned char* lds, int gw, int NGW, int wave, int lane) {
    LAS float* scr = (LAS float*)(lds + wave * 16384);
    bf16* WINT = (bf16*)(P.ws + WS_WINT); bf16* WOUTT = (bf16*)(P.ws + WS_WOUTT); bf16* XN = (bf16*)(P.ws + WS_XN);
    constexpr int I_IN = (DM / 64) * (INW / 32), I_KV = (DM / 64) * (KVW / 32), I_OUT = (DM / 64) * (DM / 32);
    for (int it = gw; it < I_IN + I_KV + I_OUT; it += NGW) {
        int r = it;
        if (r < I_IN) { p0_transpose_item(P.w_in, DM, INW, WINT, 0, scr, r, lane); continue; } r -= I_IN;
        if (r < I_KV) { p0_transpose_item(P.w_mem_kv, DM, KVW, WINT, INW, scr, r, lane); continue; } r -= I_KV;
        p0_transpose_item(P.w_out, DM, DM, WOUTT, 0, scr, r, lane);
    }
    for (int m = gw; m < MTOK + NMEM; m += NGW) {
        const float* xr = m < TP ? P.x_prompt + (size_t)m * DM : (m < MTOK ? P.x_sample + (size_t)(m - TP) * DM : P.mem_prompt + (size_t)(m - MTOK) * DM);
        rms_row_to_bf16(xr, m < MTOK ? P.g_norm : P.g_mem, XN + (size_t)m * DM, lane);
    }
    for (int it = gw; it < 8192; it += NGW) {
        const float* src = (it < 4096 ? P.cache_k : P.cache_v) + (size_t)(it & 4095) * 512 + lane * 8;
        bf16* dst = (bf16*)(P.ws + (it < 4096 ? WS_CK : WS_CV)) + (size_t)(it & 4095) * 512 + lane * 8;
        const f32x4 a = *(const GAS f32x4*)src, b = *(const GAS f32x4*)(src + 4);
        v4u o; o.x = pk2(a.x, a.y); o.y = pk2(a.z, a.w); o.z = pk2(b.x, b.y); o.w = pk2(b.z, b.w); *(GAS v4u*)dst = o;
    }
    for (int p = gw; p < SEQ + DECL; p += NGW) {
        const int pos = p < SEQ ? p : PAST + (p - SEQ);
        const float ang = (float)pos * INV_FREQ[lane];
        const double t = (double)ang * 0.15915494309189535; const float fr = (float)(t - floor(t));
        f32x2 cs; cs.x = __builtin_amdgcn_cosf(fr); cs.y = __builtin_amdgcn_sinf(fr);
        *((GAS f32x2*)(P.ws + WS_ROPE) + (size_t)p * 64 + lane) = cs;
    }
    for (int it = gw; it < 128; it += NGW) {
        const int idx = it * 512 + lane * 8, i = (idx >> 7) & 127, j0 = idx & 127;
        const f32x4 a = *(const GAS f32x4*)(P.w_s + idx), b = *(const GAS f32x4*)(P.w_s + idx + 4);
        float f[8] = {a.x, a.y, a.z, a.w, b.x, b.y, b.z, b.w};
#pragma unroll
        for (int e = 0; e < 8; ++e) f[e] = (j0 + e <= i) ? f[e] : 0.f;
        v4u o; o.x = pk2(f[0], f[1]); o.y = pk2(f[2], f[3]); o.z = pk2(f[4], f[5]); o.w = pk2(f[6], f[7]); *(GAS v4u*)((bf16*)(P.ws + WS_WTRIL) + idx) = o;
    }
}

constexpr int R_QS = 0, R_KS = 17408, R_KD = 34816, R_VS = 52224, R_PS = 69632, R_OS = 78848, R_END = 112640, RP = 272, PP = 144, OP = 528;
static_assert(R_END <= RING_BYTES, "retention LDS");
__device__ __forceinline__ void ret_unit(LAS unsigned char* lds, const bf16* proj, bf16* mix, const float* rope, const float* g_ret,
                                         int row0, int nchunks, int L, int tab0, int h, const float* S_init, float* S_out, int tid) {
    const int lane = tid & 63, w = __builtin_amdgcn_readfirstlane(tid >> 6), n_ = lane & 15, fq = lane >> 4, q_ = n_ >> 2, p_ = lane & 3;
    const float lg2 = log2f(1.0f - exp2f(-5.0f - (float)h));
    f32x4 sacc[8];
#pragma unroll
    for (int t = 0; t < 8; ++t)
#pragma unroll
        for (int r = 0; r < 4; ++r) sacc[t][r] = S_init ? S_init[(size_t)(16 * t + 4 * fq + r) * 128 + 16 * w + n_] : 0.f;
    const int lrow = tid >> 3, lc = tid & 7; const bool act = lrow < L;
    const float kdec = __builtin_amdgcn_exp2f(lg2 * (float)(L - 1 - lrow)) * 0.08838834764831845f, ksc = 0.08838834764831845f;
    const float sdec = __builtin_amdgcn_exp2f(lg2 * (float)L);
    for (int n = 0; n < nchunks; ++n) {
        {
            v4u qlo = {0u, 0u, 0u, 0u}, qhi = qlo, klo = qlo, khi = qlo, vlo = qlo, vhi = qlo; f32x4 cs[4] = {};
            if (act) { const bf16* pr = proj + (size_t)(row0 + n * 64 + lrow) * INW + 128 * h + 8 * lc;
                qlo = *(const GAS v4u*)(pr + C_RQ); qhi = *(const GAS v4u*)(pr + C_RQ + 64); klo = *(const GAS v4u*)(pr + C_RK); khi = *(const GAS v4u*)(pr + C_RK + 64);
                vlo = *(const GAS v4u*)(pr + C_RV); vhi = *(const GAS v4u*)(pr + C_RV + 64);
                const GAS f32x4* tp = (const GAS f32x4*)(rope + ((size_t)(tab0 + n * 64 + lrow) * 64 + 8 * lc) * 2);
                cs[0] = tp[0]; cs[1] = tp[1]; cs[2] = tp[2]; cs[3] = tp[3]; }
            v4u q1, q2, k1, k2, d1, d2;
#pragma unroll
            for (int e2 = 0; e2 < 4; ++e2) {
                const float c0 = cs[e2][0], s0 = cs[e2][1], c1 = cs[e2][2], s1 = cs[e2][3];
                const float qa0 = bflo(qlo[e2]), qa1 = bfhi(qlo[e2]), qb0 = bflo(qhi[e2]), qb1 = bfhi(qhi[e2]);
                const float ka0 = bflo(klo[e2]), ka1 = bfhi(klo[e2]), kb0 = bflo(khi[e2]), kb1 = bfhi(khi[e2]);
                const float qo10 = qa0 * c0 - qb0 * s0, qo11 = qa1 * c1 - qb1 * s1, qo20 = qa0 * s0 + qb0 * c0, qo21 = qa1 * s1 + qb1 * c1;
                const float ko10 = ka0 * c0 - kb0 * s0, ko11 = ka1 * c1 - kb1 * s1, ko20 = ka0 * s0 + kb0 * c0, ko21 = ka1 * s1 + kb1 * c1;
                q1[e2] = pkbf(qo10, qo11); q2[e2] = pkbf(qo20, qo21);
                k1[e2] = pkbf(ko10 * ksc, ko11 * ksc); k2[e2] = pkbf(ko20 * ksc, ko21 * ksc);
                d1[e2] = pkbf(ko10 * kdec, ko11 * kdec); d2[e2] = pkbf(ko20 * kdec, ko21 * kdec);
            }
            LAS unsigned char* rb = lds + lrow * RP + 16 * lc;
            *(LAS v4u*)(rb + R_QS) = q1; *(LAS v4u*)(rb + R_QS + 128) = q2;
            *(LAS v4u*)(rb + R_KS) = k1; *(LAS v4u*)(rb + R_KS + 128) = k2;
            *(LAS v4u*)(rb + R_KD) = d1; *(LAS v4u*)(rb + R_KD + 128) = d2;
            *(LAS v4u*)(rb + R_VS) = vlo; *(LAS v4u*)(rb + R_VS + 128) = vhi;
        }
        __syncthreads();
        {
            const int it = w >> 1, jt0 = 2 * (w & 1);
            bf16x8 aq[4];
#pragma unroll
            for (int s = 0; s < 4; ++s) aq[s] = *(const LAS bf16x8*)(lds + R_QS + (16 * it + n_) * RP + (32 * s + 8 * fq) * 2);
#pragma unroll
            for (int jj = 0; jj < 2; ++jj) { const int jt = jt0 + jj; f32x4 sc = {0.f, 0.f, 0.f, 0.f};
#pragma unroll
                for (int s = 0; s < 4; ++s) { const bf16x8 bk = *(const LAS bf16x8*)(lds + R_KS + (16 * jt + n_) * RP + (32 * s + 8 * fq) * 2); sc = mfma16(aq[s], bk, sc); }
#pragma unroll
                for (int r = 0; r < 4; ++r) { const int i = 16 * it + 4 * fq + r, j = 16 * jt + n_;
                    const float p = (i >= j) ? sc[r] * __builtin_amdgcn_exp2f(lg2 * (float)(i - j)) : 0.f;
                    *(LAS unsigned short*)(lds + R_PS + i * PP + j * 2) = (unsigned short)(pkbf(p, 0.f) & 0xffffu); }
            }
        }
        f32x4 ocr[4];
#pragma unroll
        for (int it = 0; it < 4; ++it) ocr[it] = (f32x4){0.f, 0.f, 0.f, 0.f};
#pragma unroll
        for (int s = 0; s < 4; ++s) { const bf16x8 bs = pack8(sacc[2 * s], sacc[2 * s + 1]);
#pragma unroll
            for (int it = 0; it < 4; ++it) { const LAS unsigned char* qa = lds + R_QS + (16 * it + n_) * RP + (32 * s + 4 * fq) * 2;
                const s16x4 lo = *(const LAS s16x4*)qa, hi = *(const LAS s16x4*)(qa + 32);
                ocr[it] = mfma16(cat8(lo, hi), bs, ocr[it]); } }
        __syncthreads();
        bf16x8 vf[2];
#pragma unroll
        for (int s = 0; s < 2; ++s) { LAS unsigned char* vb = lds + R_VS + (32 * s + 8 * fq + q_) * RP + (16 * w + 4 * p_) * 2; vf[s] = cat8(lds_tr(vb), lds_tr(vb + 4 * RP)); }
        f32x4 oin[4];
#pragma unroll
        for (int it = 0; it < 4; ++it) { oin[it] = (f32x4){0.f, 0.f, 0.f, 0.f};
#pragma unroll
            for (int s = 0; s < 2; ++s) { const bf16x8 ap = *(const LAS bf16x8*)(lds + R_PS + (16 * it + n_) * PP + (32 * s + 8 * fq) * 2); oin[it] = mfma16(ap, vf[s], oin[it]); } }
#pragma unroll
        for (int t = 0; t < 8; ++t) { sacc[t] = sacc[t] * sdec;
#pragma unroll
            for (int s = 0; s < 2; ++s) { LAS unsigned char* kb = lds + R_KD + (32 * s + 8 * fq + q_) * RP + (16 * t + 4 * p_) * 2; sacc[t] = mfma16(cat8(lds_tr(kb), lds_tr(kb + 4 * RP)), vf[s], sacc[t]); } }
#pragma unroll
        for (int it = 0; it < 4; ++it)
#pragma unroll
            for (int r = 0; r < 4; ++r) { const int i = 16 * it + 4 * fq + r;
                *(LAS float*)(lds + R_OS + i * OP + (16 * w + n_) * 4) = oin[it][r] + ocr[it][r] * __builtin_amdgcn_exp2f(lg2 * (float)(i + 1)); }
        __syncthreads();
        {
            f32x2 v[8]; float sm[8];
#pragma unroll
            for (int rr = 0; rr < 8; ++rr) { v[rr] = *(const LAS f32x2*)(lds + R_OS + (8 * w + rr) * OP + lane * 8); sm[rr] = v[rr].x + v[rr].y; }
#pragma unroll
            for (int rr = 0; rr < 8; ++rr) sm[rr] = wave_sum(sm[rr]) * (1.f / 128.f);
            float sq[8];
#pragma unroll
            for (int rr = 0; rr < 8; ++rr) { v[rr].x -= sm[rr]; v[rr].y -= sm[rr]; sq[rr] = v[rr].x * v[rr].x + v[rr].y * v[rr].y; }
#pragma unroll
            for (int rr = 0; rr < 8; ++rr) sq[rr] = 1.f / sqrtf(wave_sum(sq[rr]) * (1.f / 128.f) + EPS);
            const f32x2 gg = *(const GAS f32x2*)(g_ret + 128 * h + 2 * lane);
#pragma unroll
            for (int rr = 0; rr < 8; ++rr) { const int i = 8 * w + rr;
                if (i < L) { const size_t tok = (size_t)(row0 + n * 64 + i);
                    const unsigned gw_ = *(const GAS unsigned*)(proj + tok * INW + C_RG + 128 * h + 2 * lane);
                    const float y0 = v[rr].x * sq[rr] * gg.x * silu_f(bflo(gw_)), y1 = v[rr].y * sq[rr] * gg.y * silu_f(bfhi(gw_));
                    *(GAS unsigned*)(mix + tok * MIXW + MX_RO + 128 * h + 2 * lane) = pkbf(y0, y1); } }
        }
    }
#pragma unroll
    for (int t = 0; t < 8; ++t)
#pragma unroll
        for (int r = 0; r < 4; ++r) S_out[(size_t)(16 * t + 4 * fq + r) * 128 + 16 * w + n_] = sacc[t][r];
}

__device__ __forceinline__ void gmlp_unit(LAS unsigned char* lds, const bf16* proj, bf16* mix, const bf16* wtril, const float* b_s, const float* g_gmlp, float* gvs_out,
                                          int row0, int nrows, int tid) {
    const int lane = tid & 63, w = __builtin_amdgcn_readfirstlane(tid >> 6), n_ = lane & 15, fq = lane >> 4;
    LAS f32x2* st = (LAS f32x2*)lds;
    for (int rr = w; rr < nrows; rr += 8) {
        const v4u x = *(const GAS v4u*)(proj + (size_t)(row0 + rr) * INW + C_GV + 8 * lane);
        float f[8]; float s = 0.f;
#pragma unroll
        for (int e = 0; e < 8; ++e) { f[e] = bfel(x, e); s += f[e]; }
        const float mean = wave_sum(s) * (1.f / 512.f); float q = 0.f;
#pragma unroll
        for (int e = 0; e < 8; ++e) { f[e] -= mean; q += f[e] * f[e]; }
        const float rstd = 1.f / sqrtf(wave_sum(q) * (1.f / 512.f) + EPS);
        if (lane == 0) st[rr] = (f32x2){mean, rstd};
        if (gvs_out) { const f32x4 g0 = *(const GAS f32x4*)(g_gmlp + 8 * lane), g1 = *(const GAS f32x4*)(g_gmlp + 8 * lane + 4);
            f32x4 o0 = {f[0] * rstd * g0.x, f[1] * rstd * g0.y, f[2] * rstd * g0.z, f[3] * rstd * g0.w}, o1 = {f[4] * rstd * g1.x, f[5] * rstd * g1.y, f[6] * rstd * g1.z, f[7] * rstd * g1.w};
            *(GAS f32x4*)(gvs_out + (size_t)rr * 512 + 8 * lane) = o0; *(GAS f32x4*)(gvs_out + (size_t)rr * 512 + 8 * lane + 4) = o1; }
    }
    __syncthreads();
    const int mt = w;
    if (16 * mt < nrows) {
        const int smax = (16 * mt + 15) >> 5;
        for (int g = 0; g < 4; ++g) {
            f32x4 acc[8];
#pragma unroll
            for (int t = 0; t < 8; ++t) acc[t] = (f32x4){0.f, 0.f, 0.f, 0.f};
            const f32x4 ga = *(const GAS f32x4*)(g_gmlp + 128 * g + 8 * n_), gb = *(const GAS f32x4*)(g_gmlp + 128 * g + 8 * n_ + 4);
            const float gn[8] = {ga.x, ga.y, ga.z, ga.w, gb.x, gb.y, gb.z, gb.w};
            for (int s = 0; s <= smax; ++s) {
                const bf16x8 a = *(const GAS bf16x8*)(wtril + (size_t)(g * 128 + 16 * mt + n_) * 128 + 32 * s + 8 * fq);
                unsigned fw[8][4];
#pragma unroll
                for (int jp = 0; jp < 4; ++jp) {
                    const int j0 = 32 * s + 8 * fq + 2 * jp;
                    const v4u xa = *(const GAS v4u*)(proj + (size_t)(row0 + j0) * INW + C_GV + 128 * g + 8 * n_), xb = *(const GAS v4u*)(proj + (size_t)(row0 + j0 + 1) * INW + C_GV + 128 * g + 8 * n_);
                    const f32x2 sa = st[j0], sb = st[j0 + 1];
#pragma unroll
                    for (int t = 0; t < 8; ++t) fw[t][jp] = pkbf((bfel(xa, t) - sa.x) * sa.y * gn[t], (bfel(xb, t) - sb.x) * sb.y * gn[t]);
                }
#pragma unroll
                for (int t = 0; t < 8; ++t) { v4u fr_; fr_.x = fw[t][0]; fr_.y = fw[t][1]; fr_.z = fw[t][2]; fr_.w = fw[t][3]; acc[t] = mfma16(a, __builtin_bit_cast(bf16x8, fr_), acc[t]); }
            }
#pragma unroll
            for (int r = 0; r < 4; ++r) { const int i = 16 * mt + 4 * fq + r; const size_t tok = (size_t)(row0 + i); const float bias = b_s[g * 128 + i];
                const v4u gu = *(const GAS v4u*)(proj + tok * INW + C_GU + 128 * g + 8 * n_), gg = *(const GAS v4u*)(proj + tok * INW + C_GG + 128 * g + 8 * n_);
                float o[8];
#pragma unroll
                for (int t = 0; t < 8; ++t) o[t] = bfel(gu, t) * (acc[t][r] + bias) * silu_f(bfel(gg, t));
                v4u ow; ow.x = pkbf(o[0], o[1]); ow.y = pkbf(o[2], o[3]); ow.z = pkbf(o[4], o[5]); ow.w = pkbf(o[6], o[7]);
                *(GAS v4u*)(mix + tok * MIXW + MX_GO + 128 * g + 8 * n_) = ow; }
        }
    }
}

__device__ __forceinline__ void attn_task(const bf16* proj, bf16* mix, const bf16* Kp, const bf16* Vp, int pitch, int tok0, int h, int lane) {
    const int n_ = lane & 15, fq = lane >> 4;
    const bf16* qrow = proj + (size_t)(tok0 + n_) * INW;
    bf16x8 qf[4];
#pragma unroll
    for (int s = 0; s < 4; ++s) qf[s] = *(const GAS bf16x8*)(qrow + C_AQ + 128 * h + 32 * s + 8 * fq);
    f32x4 sc[16];
#pragma unroll
    for (int mt = 0; mt < 16; ++mt) { f32x4 a = {0.f, 0.f, 0.f, 0.f};
#pragma unroll
        for (int s = 0; s < 4; ++s) { const bf16x8 ka = *(const GAS bf16x8*)(Kp + (size_t)(16 * mt + n_) * pitch + 32 * s + 8 * fq); a = mfma16(ka, qf[s], a); }
        sc[mt] = a; }
    float mx = sc[0][0];
#pragma unroll
    for (int mt = 0; mt < 16; ++mt)
#pragma unroll
        for (int r = 0; r < 4; ++r) mx = fmaxf(mx, sc[mt][r]);
    mx = fmaxf(mx, __shfl_xor(mx, 16)); mx = fmaxf(mx, __shfl_xor(mx, 32));
    const float c2 = 0.08838834764831845f * 1.4426950408889634f; float l = 0.f;
#pragma unroll
    for (int mt = 0; mt < 16; ++mt)
#pragma unroll
        for (int r = 0; r < 4; ++r) { const float p = __builtin_amdgcn_exp2f((sc[mt][r] - mx) * c2); sc[mt][r] = p; l += p; }
    l += __shfl_xor(l, 16); l += __shfl_xor(l, 32);
    f32x4 ot[8];
#pragma unroll
    for (int t = 0; t < 8; ++t) ot[t] = (f32x4){0.f, 0.f, 0.f, 0.f};
#pragma unroll
    for (int s = 0; s < 8; ++s) {
        const bf16x8 bp = pack8(sc[2 * s], sc[2 * s + 1]);
        unsigned fw[8][4];
#pragma unroll
        for (int jp = 0; jp < 4; ++jp) { const int m0 = 32 * s + 16 * (jp >> 1) + 4 * fq + 2 * (jp & 1);
            const v4u xa = *(const GAS v4u*)(Vp + (size_t)m0 * pitch + 8 * n_), xb = *(const GAS v4u*)(Vp + (size_t)(m0 + 1) * pitch + 8 * n_);
#pragma unroll
            for (int t = 0; t < 8; ++t) { const unsigned wa = xa[t >> 1], wb = xb[t >> 1]; fw[t][jp] = (t & 1) ? ((wa >> 16) | (wb & 0xffff0000u)) : ((wa & 0xffffu) | (wb << 16)); } }
#pragma unroll
        for (int t = 0; t < 8; ++t) { v4u fr_; fr_.x = fw[t][0]; fr_.y = fw[t][1]; fr_.z = fw[t][2]; fr_.w = fw[t][3]; ot[t] = mfma16(__builtin_bit_cast(bf16x8, fr_), bp, ot[t]); }
    }
    const float inv = 1.f / l;
#pragma unroll
    for (int r = 0; r < 4; ++r) { const int e0 = 32 * fq + 8 * r;
        const v4u ag = *(const GAS v4u*)(qrow + C_AG + 128 * h + e0);
        float o[8];
#pragma unroll
        for (int t = 0; t < 8; ++t) o[t] = ot[t][r] * inv * silu_f(bfel(ag, t));
        v4u ow; ow.x = pkbf(o[0], o[1]); ow.y = pkbf(o[2], o[3]); ow.z = pkbf(o[4], o[5]); ow.w = pkbf(o[6], o[7]);
        *(GAS v4u*)(mix + (size_t)(tok0 + n_) * MIXW + MX_AO + 128 * h + e0) = ow; }
}

constexpr int U_RETP = 0, U_RETS = 32, U_GMP = 160, U_GMS = 288, U_ATT = 304, N_ATT_TASKS = (MTOK * 4) / 16, NUNITS = U_ATT + N_ATT_TASKS / 8;
static_assert(N_ATT_TASKS == 4224 && NUNITS == 832, "unit list");
struct Args { const float* in[16]; float* out; unsigned char* ws; };

__global__ void __launch_bounds__(NWAVES * 64, 2) fwd_megakernel(Args args) {
    extern __shared__ __attribute__((aligned(16))) unsigned char lds_raw[];
    LAS unsigned char* lds = (LAS unsigned char*)lds_raw;
    volatile LAS unsigned* MISC = (volatile LAS unsigned*)(lds + MISC_OFF);
    const int tid0 = threadIdx.x, wave = __builtin_amdgcn_readfirstlane(tid0 >> 6);
    const int G = gridDim.x, bx = blockIdx.x, vcu = (G % 8 == 0) ? (bx % 8) * (G / 8) + bx / 8 : bx;
    const int gw = vcu * NWAVES + wave, NGW = G * NWAVES;
    Ptrs P;
    P.x_prompt = args.in[0]; P.x_sample = args.in[1]; P.mem_prompt = args.in[2]; P.state_ret = args.in[3]; P.cache_k = args.in[4]; P.cache_v = args.in[5];
    P.g_norm = args.in[6]; P.w_in = args.in[7]; P.g_ret = args.in[8]; P.g_gmlp = args.in[9]; P.w_s = args.in[10]; P.b_s = args.in[11]; P.g_mem = args.in[12];
    P.w_mem_kv = args.in[13]; P.w_out = args.in[14]; P.g_final = args.in[15]; P.out = args.out; P.ws = args.ws;
    gu32* ctl = (gu32*)(P.ws + WS_CTL);
    bf16* const WINT = (bf16*)(P.ws + WS_WINT); bf16* const WOUTT = (bf16*)(P.ws + WS_WOUTT); bf16* const XN = (bf16*)(P.ws + WS_XN);
    bf16* const PROJ = (bf16*)(P.ws + WS_PROJ); bf16* const MIX = (bf16*)(P.ws + WS_MIX); bf16* const MKV = (bf16*)(P.ws + WS_MKV);
    bf16* const CK = (bf16*)(P.ws + WS_CK); bf16* const CV = (bf16*)(P.ws + WS_CV);
    const float* const ROPE = (const float*)(P.ws + WS_ROPE); float* const SSQ = (float*)(P.ws + WS_SSQ); const bf16* const WTRIL = (const bf16*)(P.ws + WS_WTRIL);

    for (int u = tid0; u < (LDS_BYTES - LDSCTL_OFF) / 4; u += NWAVES * 64) ((LAS unsigned*)(lds + LDSCTL_OFF))[u] = 0u;
    __syncthreads();
    XcdBarrier bar = xcd_barrier_post((unsigned*)(ctl + CW_BAR), MISC + 8);

#ifndef SKIP_P0
    { int l0 = tid0 & 63; asm volatile("" : "+v"(l0)); p0_prologue(P, lds, gw, NGW, wave, l0); }
#endif
    xcd_barrier(bar);

#ifndef SKIP_P1
    {
        pg8::Gemm g{XN, WINT, MTOK + NMEM, INW + KVW, DM}; pg8::Order1 S; S.init(G, bx);
        pg8::EpiProj E{PROJ, P.out + O_MK, P.out + O_MV, MKV};
        pg8::gemm_phase<pg8::EpiProj, pg8::Order1, true, true>(lds, g, S, E);
    }
#endif
    xcd_barrier(bar);

    for (;;) {
        __syncthreads();
        if (tid0 == 0) MISC[0] = __hip_atomic_fetch_add(ctl + CW_Q, 1u, RLX_AGENT);
        __syncthreads();
        const int u = (int)MISC[0];
        if (u >= NUNITS) break;
        int tid = threadIdx.x; asm volatile("" : "+v"(tid)); const int lane = tid & 63;
#ifndef SKIP_RET
        if (u < U_GMP) {
            const bool smp = u >= U_RETS; const int uu = smp ? u - U_RETS : u, sb = uu >> 3, h = uu & 7;
            ret_unit(lds, PROJ, MIX, ROPE, P.g_ret, smp ? TP + sb * DECL : sb * SEQ, smp ? 1 : SEQ / 64, smp ? DECL : 64, smp ? SEQ : 0, h,
                     smp ? P.state_ret + (size_t)uu * 16384 : nullptr, P.out + (smp ? O_SRS : O_SRP) + (size_t)uu * 16384, tid);
        } else
#endif
#ifndef SKIP_GM
        if (u < U_ATT) {
            const bool smp = u >= U_GMS; const int c = smp ? u - U_GMS : u - U_GMP;
            gmlp_unit(lds, PROJ, MIX, WTRIL, P.b_s, P.g_gmlp, smp ? P.out + O_GVS + (size_t)c * DECL * 512 : nullptr, smp ? TP + c * DECL : c * 128, smp ? DECL : 128, tid);
        } else
#endif
#ifndef SKIP_ATT
        { const int t = (u - U_ATT) * 8 + wave; const bool smp = t >= 4096;
            const int t2 = t - 4096, sb = smp ? t2 >> 3 : t >> 10, h = smp ? (t2 >> 1) & 3 : (t >> 8) & 3, qt = smp ? t2 & 1 : t & 255;
            const bf16* Kp = smp ? CK + (size_t)sb * MEMLEN * 512 + 128 * h : MKV + (size_t)sb * MEMLEN * 1024 + 128 * h;
            const bf16* Vp = smp ? CV + (size_t)sb * MEMLEN * 512 + 128 * h : MKV + (size_t)sb * MEMLEN * 1024 + 512 + 128 * h;
            attn_task(PROJ, MIX, Kp, Vp, smp ? 512 : 1024, smp ? TP + sb * DECL + 16 * qt : sb * SEQ + 16 * qt, h, lane);
        }
#endif
        {}
    }
    xcd_barrier(bar);

#ifndef SKIP_P3
    {
        pg8::Gemm g{MIX, WOUTT, MTOK, DM, DM}; pg8::StaticOrder S; S.init(MTOK, DM, G, bx);
        pg8::EpiOut E{P.x_prompt, P.x_sample, P.out + O_Y, SSQ};
        pg8::gemm_phase<pg8::EpiOut, pg8::StaticOrder, true, true>(lds, g, S, E);
    }
#endif
    xcd_barrier(bar);

    int lane4 = tid0 & 63; asm volatile("" : "+v"(lane4));
    for (int row = gw; row < MTOK; row += NGW) { const int lane = lane4;
        const float p = lane < 32 ? SSQ[(size_t)row * 32 + lane] : 0.f;
        const float rstd = 1.f / sqrtf(wave_sum(p) * (1.f / DM) + EPS);
        GAS f32x4* o = (GAS f32x4*)(P.out + O_Y + (size_t)row * DM) + lane; const GAS f32x4* gf = (const GAS f32x4*)P.g_final + lane;
#pragma unroll
        for (int j = 0; j < 8; ++j) { const f32x4 v = o[64 * j], gg = gf[64 * j]; o[64 * j] = v * rstd * gg; }
    }
}

extern "C" void kernel_launch(void* const* d_in, const int* in_sizes, int n_in, void* d_out, int out_size, void* d_ws, size_t ws_size, hipStream_t stream) {
    static int grid = 0;
    if (grid == 0) {
        if (n_in != 16 || in_sizes[0] != TP * DM || (size_t)out_size != O_END || ws_size < WS_END) {
            fprintf(stderr, "kernel_launch: unexpected shapes (n_in %d in0 %d out %d ws %zu); nothing launched\n", n_in, n_in > 0 ? in_sizes[0] : -1, out_size, ws_size); grid = -1; return; }
        int dev = 0, cus = 0, per_cu = 0;
        if (hipGetDevice(&dev) != hipSuccess || hipDeviceGetAttribute(&cus, hipDeviceAttributeMultiprocessorCount, dev) != hipSuccess) { fprintf(stderr, "kernel_launch: device query failed\n"); grid = -1; return; }
        if (hipFuncSetAttribute((const void*)fwd_megakernel, hipFuncAttributeMaxDynamicSharedMemorySize, LDS_BYTES) != hipSuccess) { fprintf(stderr, "kernel_launch: hipFuncSetAttribute failed\n"); grid = -1; return; }
        if (hipOccupancyMaxActiveBlocksPerMultiprocessor(&per_cu, (const void*)fwd_megakernel, NWAVES * 64, LDS_BYTES) != hipSuccess || per_cu < 1) {
            fprintf(stderr, "kernel_launch: occupancy query reports %d workgroups per CU\n", per_cu); (void)hipGetLastError(); per_cu = 1; }
        grid = cus;
    }
    if (grid < 0) return;
    if (hipMemsetAsync((char*)d_ws + WS_CTL, 0, CTL_ZERO_BYTES, stream) != hipSuccess) { fprintf(stderr, "kernel_launch: memset failed\n"); return; }
    Args a{};
    for (int i = 0; i < 16; ++i) a.in[i] = (const float*)d_in[i];
    a.out = (float*)d_out; a.ws = (unsigned char*)d_ws;
    hipLaunchKernelGGL(fwd_megakernel, dim3(grid), dim3(NWAVES * 64), LDS_BYTES, stream, a);
    const hipError_t le = hipPeekAtLastError();
    if (le != hipSuccess) fprintf(stderr, "kernel_launch: launch failed: %s\n", hipGetErrorName(le));
}
```

```cpp
#include <hip/hip_runtime.h>
#include <cstdio>
#include <cstdint>
namespace pg8 {
#define PG8_LAS __attribute__((address_space(3)))
typedef unsigned short bf16_t;
typedef short bf16x8 __attribute__((ext_vector_type(8)));
typedef float f32x4 __attribute__((ext_vector_type(4)));
typedef unsigned u32x4 __attribute__((ext_vector_type(4)));
constexpr int BM = 256, BK = 64, HALF = 128, HTB = HALF * BK * 2  , STAGE_BYTES = 8 * HTB, NXCD = 8, WGM = 8;

__host__ __device__ __forceinline__ int lds_byte(int r, int c) { const int st = (r >> 4) * 2 + (c >> 5), rr = r & 15, cc = c & 31, ob = rr * 64 + cc * 2; return st * 1024 + (ob ^ (((ob >> 9) & 1) << 5)); }
__host__ __device__ __forceinline__ void stage_rc(int b, int& R, int& C) { const int st = b / 1024, sb = b % 1024, swz = sb ^ (((sb >> 9) & 1) << 5); R = (st >> 1) * 16 + swz / 64; C = (st & 1) * 32 + (swz % 64) / 2; }
__host__ __device__ __forceinline__ int perm32(int rho) { const int n = rho >> 4, i = rho & 15; return 8 * (i >> 2) + 4 * n + (i & 3); }

struct Unit { int pm, pn; };
struct Gemm { const bf16_t* A; const bf16_t* Bt; int M, N, K; };

struct StaticOrder {
    int nM, nN, nwg, G, c;
    __host__ __device__ void init(int M, int N, int G_, int c_) { nM = M / BM; nN = N / BM; nwg = nM * nN; G = G_; c = c_; }
    __host__ __device__ bool next(int i, Unit& u) const {
        const long L = (long)i * G + c; if (L >= nwg) return false;
        int wgid = (int)L; { const int q = nwg / NXCD, r = nwg % NXCD, xcd = wgid % NXCD, off = wgid / NXCD; wgid = (xcd < r ? xcd * (q + 1) : r * (q + 1) + (xcd - r) * q) + off; }
        const int nig = WGM * nN, gid = wgid / nig, fm = gid * WGM, gsz = (nM - fm) < WGM ? (nM - fm) : WGM;
        u.pm = fm + ((wgid % nig) % gsz); u.pn = (wgid % nig) / gsz; return true;
    }
    __device__ __forceinline__ void a_ready(const Unit&) const {}
    __device__ __forceinline__ void done(const Unit&) const {}
};
__device__ __forceinline__ unsigned cvt_pk_bf16(float lo, float hi) { unsigned r; asm volatile("v_cvt_pk_bf16_f32 %0, %1, %2" : "=v"(r) : "v"(lo), "v"(hi)); return r; }
typedef float f32x2 __attribute__((ext_vector_type(2)));

struct Order1 {
    StaticOrder so; int G, c;
    __device__ void init(int G_, int c_) { so.init(16896, 6656, G_, c_); G = G_; c = c_; }
    __device__ bool next(int i, Unit& u) const {
        if (so.next(i, u)) return true;
        const long L = (long)i * G + c - so.nwg; if (L < 0 || L >= 16) return false;
        u.pm = 66 + (int)(L >> 2); u.pn = 26 + (int)(L & 3); return true;
    }
    __device__ __forceinline__ void a_ready(const Unit&) const {}
    __device__ __forceinline__ void done(const Unit&) const {}
};
struct EpiProj {
    static constexpr bool PERM = true, AFTER_DRAIN = false;
    bf16_t* proj; float* out_mk; float* out_mv; bf16_t* mkv; const float* rope;
    __device__ static __forceinline__ bool rope_unit(const Unit& u) { return u.pn < 8 && u.pm < 66; }
    __device__ __forceinline__ void operator()(const f32x4 (&acc)[2][2][4][2], const Unit& u, int wr, int wc, int fr, int fq) const {
        if (u.pm < 66 && u.pn < 8) {
            const bool isk = u.pn >= 4; const int hb = 2 * (u.pn & 3);
            float lg[2];
#pragma unroll
            for (int bj = 0; bj < 2; ++bj) lg[bj] = log2f(1.0f - exp2f(-5.0f - (float)(hb + bj)));
#pragma unroll
            for (int ai = 0; ai < 2; ++ai)
#pragma unroll
                for (int m = 0; m < 4; ++m) { const int row = u.pm * BM + ai * HALF + wr * 64 + m * 16 + fr;
                    const bool smp = row >= 16384; const int p = smp ? 4096 + ((row - 16384) & 31) : (row & 4095), tl = smp ? ((row - 16384) & 31) : (row & 255);
                    const float* tp = rope + ((size_t)p * 64 + 16 * wc + 4 * fq) * 2; const f32x4 t0 = *(const f32x4*)tp, t1 = *(const f32x4*)(tp + 4);
                    const float cs_[4] = {t0[0], t0[2], t1[0], t1[2]}, sn_[4] = {t0[1], t0[3], t1[1], t1[3]};
                    bf16_t* rowp = proj + (size_t)row * 6656 + u.pn * BM + 16 * wc + 4 * fq;
#pragma unroll
                    for (int bj = 0; bj < 2; ++bj) { const f32x4 x1 = acc[ai][bj][m][0], x2 = acc[ai][bj][m][1];
                        const float fac = isk ? 0.08838834764831845f * __builtin_amdgcn_exp2f(-lg[bj] * (float)tl) : __builtin_amdgcn_exp2f(lg[bj] * (float)tl);
                        float o1[4], o2[4];
#pragma unroll
                        for (int e = 0; e < 4; ++e) { o1[e] = (x1[e] * cs_[e] - x2[e] * sn_[e]) * fac; o2[e] = (x1[e] * sn_[e] + x2[e] * cs_[e]) * fac; }
                        typedef unsigned u32x2 __attribute__((ext_vector_type(2)));
                        u32x2 w1, w2; w1.x = cvt_pk_bf16(o1[0], o1[1]); w1.y = cvt_pk_bf16(o1[2], o1[3]); w2.x = cvt_pk_bf16(o2[0], o2[1]); w2.y = cvt_pk_bf16(o2[2], o2[3]);
                        *(u32x2*)(rowp + bj * HALF) = w1; *(u32x2*)(rowp + bj * HALF + 64) = w2; } }
        } else if (u.pm < 66) {
            typedef unsigned u32x2 __attribute__((ext_vector_type(2)));
            const int row0 = u.pm * BM + wr * 64 + fr, col0 = u.pn * BM + 16 * wc + 4 * fq;
#pragma unroll
            for (int ai = 0; ai < 2; ++ai)
#pragma unroll
                for (int m = 0; m < 4; ++m) { bf16_t* rowp = proj + (size_t)(row0 + ai * HALF + m * 16) * 6656 + col0;
#pragma unroll
                    for (int bj = 0; bj < 2; ++bj) { const f32x4 v0 = acc[ai][bj][m][0], v1 = acc[ai][bj][m][1];
                        u32x2 w1, w2; w1.x = cvt_pk_bf16(v0[0], v0[1]); w1.y = cvt_pk_bf16(v0[2], v0[3]); w2.x = cvt_pk_bf16(v1[0], v1[1]); w2.y = cvt_pk_bf16(v1[2], v1[3]);
                        *(u32x2*)(rowp + bj * HALF) = w1; *(u32x2*)(rowp + bj * HALF + 64) = w2; } }
        } else {
            typedef unsigned u32x2 __attribute__((ext_vector_type(2)));
            const int row0 = (u.pm - 66) * BM + wr * 64 + fr, col0 = (u.pn - 26) * BM + 16 * wc + 4 * fq;
            float* const dst0 = (u.pn - 26) < 2 ? out_mk : out_mv; const int cbase = col0 & 511;
#pragma unroll
            for (int ai = 0; ai < 2; ++ai)
#pragma unroll
                for (int m = 0; m < 4; ++m) { const int row = row0 + ai * HALF + m * 16;
#pragma unroll
                    for (int bj = 0; bj < 2; ++bj) { const f32x4 v0 = acc[ai][bj][m][0], v1 = acc[ai][bj][m][1];
                        float* d = dst0 + (size_t)row * 512 + cbase + bj * HALF; *(f32x4*)d = v0; *(f32x4*)(d + 64) = v1;
                        u32x2 w1, w2; w1.x = cvt_pk_bf16(v0[0], v0[1]); w1.y = cvt_pk_bf16(v0[2], v0[3]); w2.x = cvt_pk_bf16(v1[0], v1[1]); w2.y = cvt_pk_bf16(v1[2], v1[3]);
                        bf16_t* q = mkv + (size_t)row * 1024 + col0 + bj * HALF; *(u32x2*)q = w1; *(u32x2*)(q + 64) = w2; } }
        }
    }
};
struct EpiOut {
    static constexpr bool PERM = false, AFTER_DRAIN = false;
    __device__ static __forceinline__ bool rope_unit(const Unit&) { return false; }
    const float* xp; const float* xs; float* out; float* ssq;
    __device__ __forceinline__ void operator()(const f32x4 (&acc)[2][2][4][2], const Unit& u, int wr, int wc, int fr, int fq) const {
        const int col0 = u.pn * BM + wc * 32 + 4 * fq;
#pragma unroll
        for (int ai = 0; ai < 2; ++ai)
#pragma unroll
            for (int m = 0; m < 4; ++m) { const int row = u.pm * BM + ai * HALF + wr * 64 + m * 16 + fr;
                const float* xrow = row < 16384 ? xp + (size_t)row * 2048 : xs + (size_t)(row - 16384) * 2048; float* orow = out + (size_t)row * 2048; float s = 0.f;
#pragma unroll
                for (int bj = 0; bj < 2; ++bj)
#pragma unroll
                    for (int n = 0; n < 2; ++n) { const int c = col0 + bj * HALF + n * 16; const f32x4 o = *(const f32x4*)(xrow + c) + acc[ai][bj][m][n]; *(f32x4*)(orow + c) = o;
                        s += (o[0] * o[0] + o[1] * o[1]) + (o[2] * o[2] + o[3] * o[3]); }
                s += __shfl_xor(s, 16); s += __shfl_xor(s, 32);
                if (fq == 0) ssq[(size_t)row * 32 + u.pn * 4 + wc] = s;
                if (m & 1) asm volatile("" ::: "memory"); }
    }
};
template <class Epi, class Sched, bool ALIGN_EPI = false, bool SP2 = false>
__device__ __forceinline__ void gemm_phase(PG8_LAS unsigned char* lds, const Gemm g, const Sched& S, const Epi& E) {
    int tid_ = threadIdx.x; asm volatile("" : "+v"(tid_));
    const int tid = tid_, wid = __builtin_amdgcn_readfirstlane(tid >> 6), lane = tid & 63, wr = wid >> 2, wc = wid & 3, fr = lane & 15, fq = lane >> 4;
    const int K = g.K, nt = K / BK;
    unsigned voffA[2], voffB[2];
#pragma unroll
    for (int i = 0; i < 2; ++i) { int R, C; stage_rc(tid * 16 + i * 8192, R, C); const int Rb = Epi::PERM ? (64 * ((R >> 4) & 1) + 16 * (R >> 5) + (R & 15)) : R;
        voffA[i] = (unsigned)(R * K + C) * 2u; voffB[i] = (unsigned)(Rb * K + C) * 2u; }
    const size_t kstep = (size_t)(BK * 2);
    const size_t hstep = (size_t)HALF * K * 2;
    const size_t tstep = 2 * hstep;
    const unsigned ldsw = (unsigned)wid * 1024u;
    const int aoff = lds_byte(wr * 64 + fr, fq * 8), boff = lds_byte(wc * 32 + fr, fq * 8);
#define PG8_SA(b, h) (((b) * 2 + (h)) * HTB)
#define PG8_SB(b, h) ((4 + (b) * 2 + (h)) * HTB)
#define PG8_STAGE(bufoff, gbase, voff) do { _Pragma("unroll") for (int _i = 0; _i < 2; ++_i) \
        __builtin_amdgcn_global_load_lds((const unsigned*)((const char*)(gbase) + (voff)[_i]), (PG8_LAS unsigned*)(lds + (bufoff) + ldsw + _i * 8192), 16, 0, 0); } while (0)
#define PG8_LDA(dst, b, h) do { _Pragma("unroll") for (int m = 0; m < 4; ++m) _Pragma("unroll") for (int k = 0; k < 2; ++k) dst[m][k] = *(const PG8_LAS bf16x8*)(lds + PG8_SA(b, h) + aoff + m * 2048 + k * 1024); } while (0)
#define PG8_LDB(dst, b, h) do { _Pragma("unroll") for (int n = 0; n < 2; ++n) _Pragma("unroll") for (int k = 0; k < 2; ++k) dst[n][k] = *(const PG8_LAS bf16x8*)(lds + PG8_SB(b, h) + boff + n * 2048 + k * 1024); } while (0)
#define PG8_MMA(ai, bj, At, Bt) do { __builtin_amdgcn_s_setprio(1); _Pragma("unroll") for (int m = 0; m < 4; ++m) _Pragma("unroll") for (int n = 0; n < 2; ++n) _Pragma("unroll") for (int k = 0; k < 2; ++k) \
        acc[ai][bj][m][n] = __builtin_amdgcn_mfma_f32_16x16x32_bf16(Bt[n][k], At[m][k], acc[ai][bj][m][n], 0, 0, 0); __builtin_amdgcn_s_setprio(0); } while (0)
#define PG8_WAIT_V(n) asm volatile("s_waitcnt vmcnt(" #n ")" ::: "memory")
#define PG8_WAIT_L(n) asm volatile("s_waitcnt lgkmcnt(" #n ")" ::: "memory")
#define PG8_BAR __builtin_amdgcn_s_barrier()
#define PG8_SCHED __builtin_amdgcn_sched_barrier(0)
    Unit cur, nxt; int ui = 0;
    if (!S.next(0, cur)) return;
    f32x4 acc[2][2][4][2];
#pragma unroll
    for (int a = 0; a < 2; ++a)
#pragma unroll
        for (int b = 0; b < 2; ++b)
#pragma unroll
            for (int m = 0; m < 4; ++m)
#pragma unroll
                for (int n = 0; n < 2; ++n) acc[a][b][m][n] = (f32x4){0.f, 0.f, 0.f, 0.f};
    bf16x8 At[4][2], B0[2][2], B1[2][2];
    const char* cA = (const char*)g.A + (size_t)cur.pm * tstep; const char* cB = (const char*)g.Bt + (size_t)cur.pn * tstep;
    S.a_ready(cur);
    if constexpr (SP2) {
        PG8_STAGE(PG8_SB(0, 0), cB, voffB); PG8_STAGE(PG8_SB(0, 1), cB + hstep, voffB); PG8_STAGE(PG8_SA(0, 0), cA, voffA); PG8_STAGE(PG8_SA(0, 1), cA + hstep, voffA);
        if (wr == 1) PG8_BAR;
        PG8_WAIT_V(2); PG8_BAR;
        PG8_STAGE(PG8_SB(1, 0), cB + kstep, voffB); PG8_STAGE(PG8_SA(1, 0), cA + kstep, voffA); PG8_STAGE(PG8_SB(1, 1), cB + hstep + kstep, voffB);
        PG8_WAIT_V(6); PG8_BAR;
    } else {
        PG8_STAGE(PG8_SB(0, 0), cB, voffB); PG8_STAGE(PG8_SA(0, 0), cA, voffA); PG8_STAGE(PG8_SB(0, 1), cB + hstep, voffB); PG8_STAGE(PG8_SA(0, 1), cA + hstep, voffA);
        if (wr == 1) PG8_BAR;
        PG8_WAIT_V(4); PG8_BAR;
        PG8_STAGE(PG8_SB(1, 0), cB + kstep, voffB); PG8_STAGE(PG8_SA(1, 0), cA + kstep, voffA); PG8_STAGE(PG8_SB(1, 1), cB + hstep + kstep, voffB);
        PG8_WAIT_V(6); PG8_BAR;
    }
    for (;;) {
        const bool has_next = S.next(ui + 1, nxt);
        const char* nA = has_next ? (const char*)g.A + (size_t)nxt.pm * tstep : cA; const char* nB = has_next ? (const char*)g.Bt + (size_t)nxt.pn * tstep : cB;
        for (int t = 0; t < nt; t += 2) {
            const bool last = (t == nt - 2);
            const char* a1 = cA + (size_t)(t + 1) * kstep;
            const char* a2 = last ? nA : cA + (size_t)(t + 2) * kstep; const char* b2 = last ? nB : cB + (size_t)(t + 2) * kstep;
            const char* a3 = a2 + kstep; const char* b3 = b2 + kstep;
            if (last && has_next) S.a_ready(nxt);
            if constexpr (SP2) {
            PG8_LDB(B0, 0, 0); PG8_LDB(B1, 0, 1); PG8_SCHED; PG8_LDA(At, 0, 0); PG8_STAGE(PG8_SA(1, 1), a1 + hstep, voffA);
            PG8_WAIT_V(8); PG8_WAIT_L(0); PG8_BAR; PG8_MMA(0, 0, At, B0); PG8_MMA(0, 1, At, B1); PG8_BAR; PG8_SCHED;
            PG8_LDA(At, 0, 1); PG8_STAGE(PG8_SB(0, 0), b2, voffB); PG8_STAGE(PG8_SB(0, 1), b2 + hstep, voffB); PG8_STAGE(PG8_SA(0, 0), a2, voffA);
            PG8_WAIT_V(8); PG8_WAIT_L(0); PG8_BAR; PG8_MMA(1, 0, At, B0); PG8_MMA(1, 1, At, B1); PG8_BAR; PG8_SCHED;
            PG8_LDB(B0, 1, 0); PG8_LDB(B1, 1, 1); PG8_SCHED; PG8_LDA(At, 1, 0); PG8_STAGE(PG8_SA(0, 1), a2 + hstep, voffA);
            PG8_WAIT_V(8); PG8_WAIT_L(0); PG8_BAR; PG8_MMA(0, 0, At, B0); PG8_MMA(0, 1, At, B1); PG8_BAR; PG8_SCHED;
            PG8_LDA(At, 1, 1); PG8_STAGE(PG8_SB(1, 0), b3, voffB); PG8_STAGE(PG8_SB(1, 1), b3 + hstep, voffB); PG8_STAGE(PG8_SA(1, 0), a3, voffA);
            PG8_WAIT_V(8); PG8_WAIT_L(0); PG8_BAR; PG8_MMA(1, 0, At, B0); PG8_MMA(1, 1, At, B1); PG8_BAR; PG8_SCHED;
            } else {
            PG8_LDB(B0, 0, 0); PG8_SCHED; PG8_LDA(At, 0, 0); PG8_STAGE(PG8_SA(1, 1), a1 + hstep, voffA);
            PG8_WAIT_L(8); PG8_BAR; PG8_WAIT_L(0); PG8_MMA(0, 0, At, B0); PG8_BAR; PG8_SCHED;
            PG8_LDB(B1, 0, 1); PG8_STAGE(PG8_SB(0, 0), b2, voffB);
            PG8_BAR; PG8_WAIT_L(0); PG8_MMA(0, 1, At, B1); PG8_BAR;
            PG8_LDA(At, 0, 1); PG8_STAGE(PG8_SA(0, 0), a2, voffA);
            PG8_BAR; PG8_WAIT_L(0); PG8_MMA(1, 0, At, B0); PG8_BAR; PG8_SCHED;
            PG8_STAGE(PG8_SB(0, 1), b2 + hstep, voffB);
            PG8_WAIT_V(6); PG8_BAR; PG8_MMA(1, 1, At, B1); PG8_BAR;
            PG8_LDB(B0, 1, 0); PG8_SCHED; PG8_LDA(At, 1, 0); PG8_STAGE(PG8_SA(0, 1), a2 + hstep, voffA);
            PG8_WAIT_L(8); PG8_BAR; PG8_WAIT_L(0); PG8_MMA(0, 0, At, B0); PG8_BAR; PG8_SCHED;
            PG8_LDB(B1, 1, 1); PG8_STAGE(PG8_SB(1, 0), b3, voffB);
            PG8_BAR; PG8_WAIT_L(0); PG8_MMA(0, 1, At, B1); PG8_BAR;
            PG8_LDA(At, 1, 1); PG8_STAGE(PG8_SA(1, 0), a3, voffA);
            PG8_BAR; PG8_WAIT_L(0); PG8_MMA(1, 0, At, B0); PG8_BAR; PG8_SCHED;
            PG8_STAGE(PG8_SB(1, 1), b3 + hstep, voffB);
            PG8_WAIT_V(6); PG8_BAR; PG8_MMA(1, 1, At, B1); PG8_BAR;
            }
        }
        if constexpr (ALIGN_EPI) { if (wr == 0) PG8_BAR; }
        if constexpr (!Epi::AFTER_DRAIN) { E(acc, cur, wr, wc, fr, fq); S.done(cur); }
        if (!has_next) break;
#pragma unroll
        for (int a = 0; a < 2; ++a)
#pragma unroll
            for (int b = 0; b < 2; ++b)
#pragma unroll
                for (int m = 0; m < 4; ++m)
#pragma unroll
                    for (int n = 0; n < 2; ++n) acc[a][b][m][n] = (f32x4){0.f, 0.f, 0.f, 0.f};
        cur = nxt; cA = nA; cB = nB; ++ui;
        if constexpr (ALIGN_EPI) { if (wr == 1) PG8_BAR; }
    }
    PG8_WAIT_V(0);
    if constexpr (!ALIGN_EPI) { if (wr == 0) PG8_BAR; }
    PG8_BAR;
    if constexpr (Epi::AFTER_DRAIN) { E.fused(acc, cur, wr, wc, fr, fq, lds, wid, lane); S.done(cur); }
#undef PG8_SA
#undef PG8_SB
#undef PG8_STAGE
#undef PG8_LDA
#undef PG8_LDB
#undef PG8_MMA
#undef PG8_WAIT_V
#undef PG8_WAIT_L
#undef PG8_BAR
#undef PG8_SCHED
}
}
#define GAS __attribute__((address_space(1)))
#define LAS __attribute__((address_space(3)))
typedef unsigned short bf16;
typedef unsigned v4u __attribute__((ext_vector_type(4)));
typedef float f32x4 __attribute__((ext_vector_type(4)));
typedef short bf16x8 __attribute__((ext_vector_type(8)));
typedef GAS unsigned gu32;
typedef GAS unsigned long long gu64;
#define RLX_AGENT __ATOMIC_RELAXED, __HIP_MEMORY_SCOPE_AGENT
#define LDS_WAIT() asm volatile("s_waitcnt lgkmcnt(0)" ::: "memory")
#define VM_WAIT() asm volatile("s_waitcnt vmcnt(0)" ::: "memory")
__device__ __forceinline__ unsigned long long rt() { return __builtin_amdgcn_s_memrealtime(); }
__device__ __forceinline__ unsigned f2bf(float f) { unsigned u = __builtin_bit_cast(unsigned, f); return (u + 0x7fffu + ((u >> 16) & 1u)) >> 16; }
__device__ __forceinline__ unsigned pk2(float lo, float hi) { return f2bf(lo) | (f2bf(hi) << 16); }

#define XB_TMO      128
#define XB_XCNT(j)  (256  + 64 * (j))
#define XB_XSUB(j)  (1280 + 64 * (j))
#define XB_XGEN(j)  (2304 + 64 * (j))
#define XB_TOP      3328
#define XB_TOPGEN   3392
#define XCD_BAR_WORDS 3456
#define XB_SPIN_CAP (1u << 18)

__device__ __forceinline__ unsigned xb_ld(unsigned* p)              { return __hip_atomic_load(p, __ATOMIC_RELAXED, __HIP_MEMORY_SCOPE_AGENT); }
__device__ __forceinline__ unsigned xb_add(unsigned* p, unsigned v) { return __hip_atomic_fetch_add(p, v, __ATOMIC_RELAXED, __HIP_MEMORY_SCOPE_AGENT); }
__device__ __forceinline__ unsigned xb_xcc_id() { return (unsigned)__builtin_amdgcn_s_getreg((3 << 11) | 20) & 0xFu; }
#define XB_SPIN(cond, bar) do { unsigned _sp = 0; while (cond) { __builtin_amdgcn_s_sleep(1); \
    if ((++_sp & 255u) == 0u) { if (xb_ld(&(bar)[XB_TMO])) break; if (_sp > XB_SPIN_CAP) { atomicAdd(&(bar)[XB_TMO], 1u); break; } } } } while (0)

struct XcdBarrier {
    unsigned* bar; unsigned x;
    volatile LAS unsigned* st;
};

__device__ __forceinline__ XcdBarrier xcd_barrier_post(unsigned* bar, volatile LAS unsigned* st) {
    XcdBarrier b; b.bar = bar; b.x = xb_xcc_id(); b.st = st;
    if (threadIdx.x == 0) (void)xb_add(&bar[XB_XCNT(b.x)], 1u);
    return b;
}
__device__ __forceinline__ void xcd_barrier_complete(unsigned* bar, unsigned x, unsigned& nloc, unsigned& nx) {
    const unsigned G = gridDim.x * gridDim.y * gridDim.z;
    unsigned sum, cnt, mine, sp = 0u;
    for (;;) {
        sum = 0u; cnt = 0u; mine = 0u;
#pragma unroll
        for (unsigned j = 0; j < 16; ++j) { const unsigned c = xb_ld(&bar[XB_XCNT(j)]); sum += c; cnt += (c > 0u) ? 1u : 0u; mine = (j == x) ? c : mine; }
        if (sum == G) break;
        __builtin_amdgcn_s_sleep(1);
        if ((++sp & 255u) == 0u) { if (xb_ld(&bar[XB_TMO])) break; if (sp > XB_SPIN_CAP) { atomicAdd(&bar[XB_TMO], 1u); break; } }
    }
    nloc = mine > 0u ? mine : 1u; nx = cnt > 0u ? cnt : 1u;
}

__device__ __forceinline__ void xcd_barrier(const XcdBarrier& b) {
    asm volatile("s_waitcnt vmcnt(0)" ::: "memory");
    __syncthreads();
    if (threadIdx.x == 0) {
        unsigned* bar = b.bar;
        __builtin_amdgcn_s_waitcnt(0);
        unsigned nloc = b.st[0], nx = b.st[1];
        if (nloc == 0u) { xcd_barrier_complete(bar, b.x, nloc, nx); b.st[0] = nloc; b.st[1] = nx; }
        const unsigned old = xb_add(&bar[XB_XSUB(b.x)], 1u);
        const unsigned gen = old / nloc;
        if (old + 1u == (gen + 1u) * nloc) {
            __builtin_amdgcn_fence(__ATOMIC_RELEASE, "agent");
            asm volatile("s_waitcnt vmcnt(0)" ::: "memory");
            const unsigned og = xb_add(&bar[XB_TOP], 1u);
            const unsigned tg = og / nx;
            if (og + 1u == (tg + 1u) * nx) xb_add(&bar[XB_TOPGEN], 1u);
            else XB_SPIN(xb_ld(&bar[XB_TOPGEN]) == tg, bar);
            __builtin_amdgcn_fence(__ATOMIC_ACQUIRE, "agent");
            xb_add(&bar[XB_XGEN(b.x)], 1u);
            asm volatile("s_waitcnt vmcnt(0)" ::: "memory");
        } else {
            XB_SPIN(xb_ld(&bar[XB_XGEN(b.x)]) == gen, bar);
            __builtin_amdgcn_fence(__ATOMIC_ACQUIRE, "agent");
            asm volatile("s_waitcnt vmcnt(0)" ::: "memory");
        }
    }
    __syncthreads();
}

constexpr int NWAVES = 8;
constexpr int DM = 2048, TP = 16384, TS = 512, MTOK = TP + TS, SEQ = 4096, NBATCH = 4, DECB = 16, DECL = 32, PAST = 1024, MEMLEN = 256, NMEM = NBATCH * MEMLEN;
constexpr int INW = 6656, KVW = 1024;
constexpr int C_RQ = 0, C_RK = 1024, C_RV = 2048, C_RG = 3072, C_GU = 4096, C_GV = 4608, C_GG = 5120, C_AQ = 5632, C_AG = 6144;
constexpr int MIXW = 2048, MX_RO = 0, MX_GO = 1024, MX_AO = 1536;
constexpr float EPS = 1e-6f;
constexpr size_t O_Y = 0, O_SRP = (size_t)MTOK * DM, O_MK = O_SRP + 4 * 8 * 128 * 128, O_MV = O_MK + (size_t)NMEM * 512, O_SRS = O_MV + (size_t)NMEM * 512,
                 O_GVS = O_SRS + (size_t)DECB * 8 * 128 * 128, O_END = O_GVS + (size_t)DECB * DECL * 512;
static_assert(O_END == 38535168, "d_out size");
constexpr size_t MiB = 1u << 20;
constexpr size_t WS_CTL = 0, CTL_ZERO_BYTES = 1 * MiB;
constexpr size_t WS_WINT = 2 * MiB;
constexpr size_t WS_WOUTT = 32 * MiB;
constexpr size_t WS_XN = 40 * MiB;
constexpr size_t WS_PROJ = 112 * MiB;
constexpr size_t WS_MIX = 328 * MiB;
constexpr size_t WS_MKV = 394 * MiB;
constexpr size_t WS_CK = 396 * MiB, WS_CV = 400 * MiB;
constexpr size_t WS_ROPE = 404 * MiB;
constexpr size_t WS_SSQ = 407 * MiB;
constexpr size_t WS_WTRIL = 410 * MiB;
constexpr size_t WS_U = 412 * MiB;
constexpr size_t WS_ST = 444 * MiB;
constexpr size_t WS_STS = 460 * MiB;
constexpr size_t WS_END = 464 * MiB;
constexpr int CW_BAR = 4096;
constexpr int CW_Q1 = 64, CW_Q2 = 128, CW_Q3 = 192, CW_D1 = 256, CW_D2 = 320, CW_ATT = 384;
constexpr int RING_BYTES = 131072, LDS_BYTES = 147456, LDSCTL_OFF = LDS_BYTES - 512, MISC_OFF = LDSCTL_OFF + 320;
static_assert(MISC_OFF + 128 <= LDS_BYTES, "LDS map");

__device__ const float INV_FREQ[64] = {
1.000000000e+00f, 8.659643531e-01f, 7.498942018e-01f, 6.493816376e-01f, 5.623413324e-01f, 4.869675338e-01f, 4.216965139e-01f, 3.651741147e-01f,
3.162277639e-01f, 2.738419771e-01f, 2.371373773e-01f, 2.053525001e-01f, 1.778279394e-01f, 1.539926529e-01f, 1.333521456e-01f, 1.154781953e-01f,
1.000000015e-01f, 8.659642935e-02f, 7.498942316e-02f, 6.493816525e-02f, 5.623413250e-02f, 4.869675264e-02f, 4.216964915e-02f, 3.651741147e-02f,
3.162277490e-02f, 2.738419548e-02f, 2.371373773e-02f, 2.053525113e-02f, 1.778279431e-02f, 1.539926510e-02f, 1.333521400e-02f, 1.154781971e-02f,
9.999999776e-03f, 8.659643121e-03f, 7.498942316e-03f, 6.493816152e-03f, 5.623413250e-03f, 4.869675264e-03f, 4.216964822e-03f, 3.651741194e-03f,
3.162277630e-03f, 2.738419687e-03f, 2.371373819e-03f, 2.053525066e-03f, 1.778279431e-03f, 1.539926510e-03f, 1.333521446e-03f, 1.154782018e-03f,
1.000000047e-03f, 8.659643354e-04f, 7.498941850e-04f, 6.493816036e-04f, 5.623413017e-04f, 4.869675322e-04f, 4.216965172e-04f, 3.651741135e-04f,
3.162277571e-04f, 2.738419571e-04f, 2.371373703e-04f, 2.053525095e-04f, 1.778279402e-04f, 1.539926598e-04f, 1.333521504e-04f, 1.154782003e-04f
};

typedef short s16x4 __attribute__((ext_vector_type(4)));
typedef unsigned u32x2 __attribute__((ext_vector_type(2)));
typedef float f32x2 __attribute__((ext_vector_type(2)));
typedef __bf16 bf16x2_t __attribute__((ext_vector_type(2)));
typedef short v4i16_t __attribute__((ext_vector_type(4)));
__device__ __forceinline__ unsigned pkbf(float lo, float hi) { f32x2 v = {lo, hi}; bf16x2_t b = __builtin_convertvector(v, bf16x2_t); return __builtin_bit_cast(unsigned, b); }
__device__ __forceinline__ float bflo(unsigned w) { return __uint_as_float(w << 16); }
__device__ __forceinline__ float bfhi(unsigned w) { return __uint_as_float(w & 0xffff0000u); }
__device__ __forceinline__ float bfel(const v4u& x, int e) { const unsigned w = x[e >> 1]; return (e & 1) ? bfhi(w) : bflo(w); }
__device__ __forceinline__ float silu_f(float x) { return x * __builtin_amdgcn_rcpf(1.0f + __builtin_amdgcn_exp2f(-1.4426950408889634f * x)); }
__device__ __forceinline__ float wave_sum(float v) {
#pragma unroll
    for (int o = 1; o < 64; o <<= 1) v += __shfl_xor(v, o);
    return v;
}
__device__ __forceinline__ f32x4 mfma16(bf16x8 a, bf16x8 b, f32x4 c) { return __builtin_amdgcn_mfma_f32_16x16x32_bf16(a, b, c, 0, 0, 0); }
__device__ __forceinline__ s16x4 lds_tr(LAS unsigned char* p) { return __builtin_bit_cast(s16x4, __builtin_amdgcn_ds_read_tr16_b64_v4i16((LAS v4i16_t*)p)); }
__device__ __forceinline__ bf16x8 cat8(s16x4 lo, s16x4 hi) { return (bf16x8){lo[0], lo[1], lo[2], lo[3], hi[0], hi[1], hi[2], hi[3]}; }
__device__ __forceinline__ bf16x8 pack8(const f32x4& a, const f32x4& b) { v4u w; w.x = pkbf(a[0], a[1]); w.y = pkbf(a[2], a[3]); w.z = pkbf(b[0], b[1]); w.w = pkbf(b[2], b[3]); return __builtin_bit_cast(bf16x8, w); }

__device__ __forceinline__ void p0_transpose_item(const float* W, int K, int N, bf16* WT, int row_off, LAS float* scr, int item, int lane) {
    const int nblk = N / 32, kb = item / nblk, nb = item % nblk, k0 = 64 * kb, n0 = 32 * nb;
#pragma unroll 8
    for (int i = 0; i < 32; ++i) { const int kk = 2 * i + (lane >> 5); scr[kk * 33 + (lane & 31)] = W[(size_t)(k0 + kk) * N + n0 + (lane & 31)]; }
    LDS_WAIT(); asm volatile("" ::: "memory");
    const int c = lane & 7;
#pragma unroll
    for (int j = 0; j < 4; ++j) { const int n = (lane >> 3) + 8 * j; const LAS float* s = scr + (8 * c) * 33 + n;
        v4u o; o.x = pk2(s[0 * 33], s[1 * 33]); o.y = pk2(s[2 * 33], s[3 * 33]); o.z = pk2(s[4 * 33], s[5 * 33]); o.w = pk2(s[6 * 33], s[7 * 33]);
        *(GAS v4u*)(WT + (size_t)(row_off + n0 + n) * K + k0 + 8 * c) = o; }
    LDS_WAIT(); asm volatile("" ::: "memory");
}
__device__ __forceinline__ void rms_row_to_bf16(const float* xrow, const float* g, bf16* orow, int lane) {
    const GAS f32x4* xr = (const GAS f32x4*)xrow + lane; const GAS f32x4* gr = (const GAS f32x4*)g + lane;
    f32x4 v[8]; float s = 0.f;
#pragma unroll
    for (int j = 0; j < 8; ++j) { v[j] = xr[64 * j]; s += (v[j].x * v[j].x + v[j].y * v[j].y) + (v[j].z * v[j].z + v[j].w * v[j].w); }
    const float rstd = 1.f / sqrtf(wave_sum(s) * (1.f / DM) + EPS);
    GAS unsigned long long* o8 = (GAS unsigned long long*)orow + lane;
#pragma unroll
    for (int j = 0; j < 8; ++j) { const f32x4 gg = gr[64 * j];
        o8[64 * j] = (unsigned long long)pk2(v[j].x * rstd * gg.x, v[j].y * rstd * gg.y) | ((unsigned long long)pk2(v[j].z * rstd * gg.z, v[j].w * rstd * gg.w) << 32); }
}
struct Ptrs {
    const float *x_prompt, *x_sample, *mem_prompt, *state_ret, *cache_k, *cache_v, *g_norm, *w_in, *g_ret, *g_gmlp, *w_s, *b_s, *g_mem, *w_mem_kv, *w_out, *g_final;
    float* out; unsigned char* ws;
};
__device__ __forceinline__ void p0_prologue(const Ptrs& P, LAS unsigned char* lds, int gw, int NGW, int wave, int lane) {
    LAS float* scr = (LAS float*)(lds + wave * 16384);
    bf16* WINT = (bf16*)(P.ws + WS_WINT); bf16* WOUTT = (bf16*)(P.ws + WS_WOUTT); bf16* XN = (bf16*)(P.ws + WS_XN);
    constexpr int I_IN = (DM / 64) * (INW / 32), I_KV = (DM / 64) * (KVW / 32), I_OUT = (DM / 64) * (DM / 32);
    for (int it = gw; it < I_IN + I_KV + I_OUT; it += NGW) {
        int r = it;
        if (r < I_IN) { p0_transpose_item(P.w_in, DM, INW, WINT, 0, scr, r, lane); continue; } r -= I_IN;
        if (r < I_KV) { p0_transpose_item(P.w_mem_kv, DM, KVW, WINT, INW, scr, r, lane); continue; } r -= I_KV;
        p0_transpose_item(P.w_out, DM, DM, WOUTT, 0, scr, r, lane);
    }
    for (int m = gw; m < MTOK + NMEM; m += NGW) {
        const float* xr = m < TP ? P.x_prompt + (size_t)m * DM : (m < MTOK ? P.x_sample + (size_t)(m - TP) * DM : P.mem_prompt + (size_t)(m - MTOK) * DM);
        rms_row_to_bf16(xr, m < MTOK ? P.g_norm : P.g_mem, XN + (size_t)m * DM, lane);
    }
    for (int it = gw; it < 8192; it += NGW) {
        const float* src = (it < 4096 ? P.cache_k : P.cache_v) + (size_t)(it & 4095) * 512 + lane * 8;
        bf16* dst = (bf16*)(P.ws + (it < 4096 ? WS_CK : WS_CV)) + (size_t)(it & 4095) * 512 + lane * 8;
        const f32x4 a = *(const GAS f32x4*)src, b = *(const GAS f32x4*)(src + 4);
        v4u o; o.x = pk2(a.x, a.y); o.y = pk2(a.z, a.w); o.z = pk2(b.x, b.y); o.w = pk2(b.z, b.w); *(GAS v4u*)dst = o;
    }
    for (int p = gw; p < SEQ + DECL; p += NGW) {
        const int pos = p < SEQ ? p : PAST + (p - SEQ);
        const float ang = (float)pos * INV_FREQ[lane];
        const double t = (double)ang * 0.15915494309189535; const float fr = (float)(t - floor(t));
        f32x2 cs; cs.x = __builtin_amdgcn_cosf(fr); cs.y = __builtin_amdgcn_sinf(fr);
        *((GAS f32x2*)(P.ws + WS_ROPE) + (size_t)p * 64 + lane) = cs;
    }
    for (int it = gw; it < 128; it += NGW) {
        const int idx = it * 512 + lane * 8, i = (idx >> 7) & 127, j0 = idx & 127;
        const f32x4 a = *(const GAS f32x4*)(P.w_s + idx), b = *(const GAS f32x4*)(P.w_s + idx + 4);
        float f[8] = {a.x, a.y, a.z, a.w, b.x, b.y, b.z, b.w};
#pragma unroll
        for (int e = 0; e < 8; ++e) f[e] = (j0 + e <= i) ? f[e] : 0.f;
        v4u o; o.x = pk2(f[0], f[1]); o.y = pk2(f[2], f[3]); o.z = pk2(f[4], f[5]); o.w = pk2(f[6], f[7]); *(GAS v4u*)((bf16*)(P.ws + WS_WTRIL) + idx) = o;
    }
}

constexpr int RP = 272, R2_V = 256 * RP, R2_END = 2 * 256 * RP;
__device__ __forceinline__ void ret_load_kv(LAS unsigned char* lds, const bf16* proj, int row0, int nk, int h, int tid) {
    const int c = tid & 15, r0 = tid >> 4;
    if (nk == 256) {
        v4u kx[8], vx[8];
#pragma unroll
        for (int i = 0; i < 8; ++i) { const bf16* pr = proj + (size_t)(row0 + r0 + 32 * i) * INW + 128 * h + 8 * c; kx[i] = *(const GAS v4u*)(pr + C_RK); vx[i] = *(const GAS v4u*)(pr + C_RV); }
#pragma unroll
        for (int i = 0; i < 8; ++i) { LAS unsigned char* d = lds + (r0 + 32 * i) * RP + 16 * c; *(LAS v4u*)d = kx[i]; *(LAS v4u*)(d + R2_V) = vx[i]; }
    } else {
        const bf16* pr = proj + (size_t)(row0 + r0) * INW + 128 * h + 8 * c; const v4u kx = *(const GAS v4u*)(pr + C_RK), vx = *(const GAS v4u*)(pr + C_RV);
        LAS unsigned char* d = lds + r0 * RP + 16 * c; *(LAS v4u*)d = kx; *(LAS v4u*)(d + R2_V) = vx;
    }
}
__device__ __forceinline__ void retA_unit(LAS unsigned char* lds, const bf16* proj, int row0, int nk, int h, const float* S0, float* Uout, int tid) {
    const int lane = tid & 63, w = __builtin_amdgcn_readfirstlane(tid >> 6), n_ = lane & 15, fq = lane >> 4, q_ = n_ >> 2, p_ = lane & 3;
    ret_load_kv(lds, proj, row0, nk, h, tid);
    __syncthreads();
    f32x4 acc[8];
#pragma unroll
    for (int t = 0; t < 8; ++t) acc[t] = (f32x4){0.f, 0.f, 0.f, 0.f};
    const int ns = nk >> 5;
    for (int s = 0; s < ns; ++s) {
        LAS unsigned char* vb = lds + R2_V + (32 * s + 8 * fq + q_) * RP + (16 * w + 4 * p_) * 2; const bf16x8 vf = cat8(lds_tr(vb), lds_tr(vb + 4 * RP));
#pragma unroll
        for (int t = 0; t < 8; ++t) { LAS unsigned char* kb = lds + (32 * s + 8 * fq + q_) * RP + (16 * t + 4 * p_) * 2; acc[t] = mfma16(cat8(lds_tr(kb), lds_tr(kb + 4 * RP)), vf, acc[t]); }
    }
    float a0 = 0.f, a1 = 1.f;
    if (S0) { const float lg2 = log2f(1.0f - exp2f(-5.0f - (float)h)); a0 = __builtin_amdgcn_exp2f(lg2 * 32.f); a1 = __builtin_amdgcn_exp2f(lg2 * 31.f); }
#pragma unroll
    for (int t = 0; t < 8; ++t)
#pragma unroll
        for (int r = 0; r < 4; ++r) { const size_t o = (size_t)(16 * t + 4 * fq + r) * 128 + 16 * w + n_; Uout[o] = S0 ? a0 * S0[o] + a1 * acc[t][r] : acc[t][r]; }
}
__device__ __forceinline__ void retB_item(const float* U, bf16* ST, const float* S0s, bf16* STS, float* Send, int item, int lane) {
    if (item < 1024) {
        const int bh = item >> 5, wv = item & 31, e = (wv & 1) * 64 + lane, d0 = (wv >> 1) * 8, h = bh & 7;
        const float lg2 = log2f(1.0f - exp2f(-5.0f - (float)h)), g256 = __builtin_amdgcn_exp2f(lg2 * 256.f), g255 = __builtin_amdgcn_exp2f(lg2 * 255.f);
        float S[8];
#pragma unroll
        for (int j = 0; j < 8; ++j) S[j] = 0.f;
        for (int m = 0; m < 16; ++m) {
            const size_t mb = (size_t)(bh * 16 + m) * 16384;
            v4u o; o.x = pkbf(S[0], S[1]); o.y = pkbf(S[2], S[3]); o.z = pkbf(S[4], S[5]); o.w = pkbf(S[6], S[7]);
            *(GAS v4u*)(ST + mb + (size_t)e * 128 + d0) = o;
#pragma unroll
            for (int j = 0; j < 8; ++j) S[j] = g256 * S[j] + g255 * U[mb + (size_t)(d0 + j) * 128 + e];
        }
#pragma unroll
        for (int j = 0; j < 8; ++j) Send[(size_t)bh * 16384 + (size_t)(d0 + j) * 128 + e] = S[j];
    } else {
        const int it = item - 1024, sh = it >> 5, wv = it & 31, e = (wv & 1) * 64 + lane, d0 = (wv >> 1) * 8;
        float S[8];
#pragma unroll
        for (int j = 0; j < 8; ++j) S[j] = S0s[(size_t)sh * 16384 + (size_t)(d0 + j) * 128 + e];
        v4u o; o.x = pkbf(S[0], S[1]); o.y = pkbf(S[2], S[3]); o.z = pkbf(S[4], S[5]); o.w = pkbf(S[6], S[7]);
        *(GAS v4u*)(STS + (size_t)sh * 16384 + (size_t)e * 128 + d0) = o;
    }
}
__device__ __forceinline__ void retC_qtile(LAS unsigned char* lds, const bf16* proj, bf16* mix, const bf16* STp, const float* g_ret, int row0, int qt, int h, float gamma, int lane) {
    const int n_ = lane & 15, fq = lane >> 4, q_ = n_ >> 2, p_ = lane & 3;
    const size_t tokq = (size_t)(row0 + 16 * qt + n_);
    bf16x8 qf[4];
#pragma unroll
    for (int s = 0; s < 4; ++s) qf[s] = *(const GAS bf16x8*)(proj + tokq * INW + C_RQ + 128 * h + 32 * s + 8 * fq);
    f32x4 ot[8];
#pragma unroll
    for (int et = 0; et < 8; ++et) { f32x4 a = {0.f, 0.f, 0.f, 0.f};
#pragma unroll
        for (int s = 0; s < 4; ++s) { const bf16x8 sa = *(const GAS bf16x8*)(STp + (size_t)(16 * et + n_) * 128 + 32 * s + 8 * fq); a = mfma16(sa, qf[s], a); }
        ot[et] = a * gamma; }
    const int np = (qt >> 1) + 1;
    for (int s2 = 0; s2 < np; ++s2) {
        const int jt0 = 2 * s2, jt1 = jt0 + 1;
        f32x4 sc0 = {0.f, 0.f, 0.f, 0.f}, sc1 = {0.f, 0.f, 0.f, 0.f};
#pragma unroll
        for (int s = 0; s < 4; ++s) { const bf16x8 ka = *(const LAS bf16x8*)(lds + (16 * jt0 + n_) * RP + (32 * s + 8 * fq) * 2); sc0 = mfma16(ka, qf[s], sc0); }
        if (jt1 <= qt) {
#pragma unroll
            for (int s = 0; s < 4; ++s) { const bf16x8 kb = *(const LAS bf16x8*)(lds + (16 * jt1 + n_) * RP + (32 * s + 8 * fq) * 2); sc1 = mfma16(kb, qf[s], sc1); }
        }
        if (jt0 == qt) {
#pragma unroll
            for (int r = 0; r < 4; ++r) sc0[r] = (4 * fq + r > n_) ? 0.f : sc0[r];
        }
        if (jt1 == qt) {
#pragma unroll
            for (int r = 0; r < 4; ++r) sc1[r] = (4 * fq + r > n_) ? 0.f : sc1[r];
        }
        const bf16x8 bp = pack8(sc0, sc1);
#pragma unroll
        for (int et = 0; et < 8; ++et) { LAS unsigned char* vb = lds + R2_V + (32 * s2 + 4 * fq + q_) * RP + (16 * et + 4 * p_) * 2;
            ot[et] = mfma16(cat8(lds_tr(vb), lds_tr(vb + 16 * RP)), bp, ot[et]); }
    }
    float sm = 0.f;
#pragma unroll
    for (int et = 0; et < 8; ++et) sm += (ot[et][0] + ot[et][1]) + (ot[et][2] + ot[et][3]);
    sm += __shfl_xor(sm, 16); sm += __shfl_xor(sm, 32);
    const float mean = sm * (1.f / 128.f); float sq = 0.f;
#pragma unroll
    for (int et = 0; et < 8; ++et) { ot[et] = ot[et] - mean; sq += (ot[et][0] * ot[et][0] + ot[et][1] * ot[et][1]) + (ot[et][2] * ot[et][2] + ot[et][3] * ot[et][3]); }
    sq += __shfl_xor(sq, 16); sq += __shfl_xor(sq, 32);
    const float rstd = 1.f / sqrtf(sq * (1.f / 128.f) + EPS);
#pragma unroll
    for (int et = 0; et < 8; ++et) { const int e0 = 128 * h + 16 * et + 4 * fq;
        const u32x2 gw_ = *(const GAS u32x2*)(proj + tokq * INW + C_RG + e0); const f32x4 gg = *(const GAS f32x4*)(g_ret + e0);
        u32x2 o; o.x = pkbf(ot[et][0] * rstd * gg[0] * silu_f(bflo(gw_.x)), ot[et][1] * rstd * gg[1] * silu_f(bfhi(gw_.x)));
        o.y = pkbf(ot[et][2] * rstd * gg[2] * silu_f(bflo(gw_.y)), ot[et][3] * rstd * gg[3] * silu_f(bfhi(gw_.y)));
        *(GAS u32x2*)(mix + tokq * MIXW + MX_RO + e0) = o; }
}
__device__ __forceinline__ void retC_unit(LAS unsigned char* lds, const bf16* proj, bf16* mix, const bf16* STp, const float* g_ret, int row0, int nk, int h, int tid) {
    const int lane = tid & 63, w = __builtin_amdgcn_readfirstlane(tid >> 6);
    ret_load_kv(lds, proj, row0, nk, h, tid);
    __syncthreads();
    const float gamma = 1.0f - exp2f(-5.0f - (float)h);
    const int nq = nk == 256 ? 2 : (w < 2 ? 1 : 0);
#pragma unroll 1
    for (int k = 0; k < nq; ++k) retC_qtile(lds, proj, mix, STp, g_ret, row0, k == 0 ? w : 15 - w, h, gamma, lane);
}

__device__ __forceinline__ void gmlp_unit(LAS unsigned char* lds, const bf16* proj, bf16* mix, const bf16* wtril, const float* b_s, const float* g_gmlp, float* gvs_out,
                                          int row0, int nrows, int tid) {
    const int lane = tid & 63, w = __builtin_amdgcn_readfirstlane(tid >> 6), n_ = lane & 15, fq = lane >> 4;
    LAS f32x2* st = (LAS f32x2*)lds;
    for (int rr = w; rr < nrows; rr += 8) {
        const v4u x = *(const GAS v4u*)(proj + (size_t)(row0 + rr) * INW + C_GV + 8 * lane);
        float f[8]; float s = 0.f;
#pragma unroll
        for (int e = 0; e < 8; ++e) { f[e] = bfel(x, e); s += f[e]; }
        const float mean = wave_sum(s) * (1.f / 512.f); float q = 0.f;
#pragma unroll
        for (int e = 0; e < 8; ++e) { f[e] -= mean; q += f[e] * f[e]; }
        const float rstd = 1.f / sqrtf(wave_sum(q) * (1.f / 512.f) + EPS);
        if (lane == 0) st[rr] = (f32x2){mean, rstd};
        if (gvs_out) { const f32x4 g0 = *(const GAS f32x4*)(g_gmlp + 8 * lane), g1 = *(const GAS f32x4*)(g_gmlp + 8 * lane + 4);
            f32x4 o0 = {f[0] * rstd * g0.x, f[1] * rstd * g0.y, f[2] * rstd * g0.z, f[3] * rstd * g0.w}, o1 = {f[4] * rstd * g1.x, f[5] * rstd * g1.y, f[6] * rstd * g1.z, f[7] * rstd * g1.w};
            *(GAS f32x4*)(gvs_out + (size_t)rr * 512 + 8 * lane) = o0; *(GAS f32x4*)(gvs_out + (size_t)rr * 512 + 8 * lane + 4) = o1; }
    }
    __syncthreads();
    const int mt = w;
    if (16 * mt < nrows) {
        const int smax = (16 * mt + 15) >> 5;
        for (int g = 0; g < 4; ++g) {
            f32x4 acc[8];
#pragma unroll
            for (int t = 0; t < 8; ++t) acc[t] = (f32x4){0.f, 0.f, 0.f, 0.f};
            const f32x4 ga = *(const GAS f32x4*)(g_gmlp + 128 * g + 8 * n_), gb = *(const GAS f32x4*)(g_gmlp + 128 * g + 8 * n_ + 4);
            const float gn[8] = {ga.x, ga.y, ga.z, ga.w, gb.x, gb.y, gb.z, gb.w};
            for (int s = 0; s <= smax; ++s) {
                const bf16x8 a = *(const GAS bf16x8*)(wtril + (size_t)(g * 128 + 16 * mt + n_) * 128 + 32 * s + 8 * fq);
                unsigned fw[8][4];
#pragma unroll
                for (int jp = 0; jp < 4; ++jp) {
                    const int j0 = 32 * s + 8 * fq + 2 * jp;
                    const v4u xa = *(const GAS v4u*)(proj + (size_t)(row0 + j0) * INW + C_GV + 128 * g + 8 * n_), xb = *(const GAS v4u*)(proj + (size_t)(row0 + j0 + 1) * INW + C_GV + 128 * g + 8 * n_);
                    const f32x2 sa = st[j0], sb = st[j0 + 1];
#pragma unroll
                    for (int t = 0; t < 8; ++t) fw[t][jp] = pkbf((bfel(xa, t) - sa.x) * sa.y * gn[t], (bfel(xb, t) - sb.x) * sb.y * gn[t]);
                }
#pragma unroll
                for (int t = 0; t < 8; ++t) { v4u fr_; fr_.x = fw[t][0]; fr_.y = fw[t][1]; fr_.z = fw[t][2]; fr_.w = fw[t][3]; acc[t] = mfma16(a, __builtin_bit_cast(bf16x8, fr_), acc[t]); }
            }
#pragma unroll
            for (int r = 0; r < 4; ++r) { const int i = 16 * mt + 4 * fq + r; const size_t tok = (size_t)(row0 + i); const float bias = b_s[g * 128 + i];
                const v4u gu = *(const GAS v4u*)(proj + tok * INW + C_GU + 128 * g + 8 * n_), gg = *(const GAS v4u*)(proj + tok * INW + C_GG + 128 * g + 8 * n_);
                float o[8];
#pragma unroll
                for (int t = 0; t < 8; ++t) o[t] = bfel(gu, t) * (acc[t][r] + bias) * silu_f(bfel(gg, t));
                v4u ow; ow.x = pkbf(o[0], o[1]); ow.y = pkbf(o[2], o[3]); ow.z = pkbf(o[4], o[5]); ow.w = pkbf(o[6], o[7]);
                *(GAS v4u*)(mix + tok * MIXW + MX_GO + 128 * g + 8 * n_) = ow; }
        }
    }
}

__device__ __forceinline__ void attn_task(const bf16* proj, bf16* mix, const bf16* Kp, const bf16* Vp, int pitch, int tok0, int h, int lane) {
    const int n_ = lane & 15, fq = lane >> 4;
    const bf16* qrow = proj + (size_t)(tok0 + n_) * INW;
    bf16x8 qf[4];
#pragma unroll
    for (int s = 0; s < 4; ++s) qf[s] = *(const GAS bf16x8*)(qrow + C_AQ + 128 * h + 32 * s + 8 * fq);
    f32x4 sc[16];
#pragma unroll
    for (int mt = 0; mt < 16; ++mt) { f32x4 a = {0.f, 0.f, 0.f, 0.f};
#pragma unroll
        for (int s = 0; s < 4; ++s) { const bf16x8 ka = *(const GAS bf16x8*)(Kp + (size_t)(16 * mt + n_) * pitch + 32 * s + 8 * fq); a = mfma16(ka, qf[s], a); }
        sc[mt] = a; }
    float mx = sc[0][0];
#pragma unroll
    for (int mt = 0; mt < 16; ++mt)
#pragma unroll
        for (int r = 0; r < 4; ++r) mx = fmaxf(mx, sc[mt][r]);
    mx = fmaxf(mx, __shfl_xor(mx, 16)); mx = fmaxf(mx, __shfl_xor(mx, 32));
    const float c2 = 0.08838834764831845f * 1.4426950408889634f; float l = 0.f;
#pragma unroll
    for (int mt = 0; mt < 16; ++mt)
#pragma unroll
        for (int r = 0; r < 4; ++r) { const float p = __builtin_amdgcn_exp2f((sc[mt][r] - mx) * c2); sc[mt][r] = p; l += p; }
    l += __shfl_xor(l, 16); l += __shfl_xor(l, 32);
    f32x4 ot[8];
#pragma unroll
    for (int t = 0; t < 8; ++t) ot[t] = (f32x4){0.f, 0.f, 0.f, 0.f};
#pragma unroll
    for (int s = 0; s < 8; ++s) {
        const bf16x8 bp = pack8(sc[2 * s], sc[2 * s + 1]);
        unsigned fw[8][4];
#pragma unroll
        for (int jp = 0; jp < 4; ++jp) { const int m0 = 32 * s + 16 * (jp >> 1) + 4 * fq + 2 * (jp & 1);
            const v4u xa = *(const GAS v4u*)(Vp + (size_t)m0 * pitch + 8 * n_), xb = *(const GAS v4u*)(Vp + (size_t)(m0 + 1) * pitch + 8 * n_);
#pragma unroll
            for (int t = 0; t < 8; ++t) { const unsigned wa = xa[t >> 1], wb = xb[t >> 1]; fw[t][jp] = (t & 1) ? ((wa >> 16) | (wb & 0xffff0000u)) : ((wa & 0xffffu) | (wb << 16)); } }
#pragma unroll
        for (int t = 0; t < 8; ++t) { v4u fr_; fr_.x = fw[t][0]; fr_.y = fw[t][1]; fr_.z = fw[t][2]; fr_.w = fw[t][3]; ot[t] = mfma16(__builtin_bit_cast(bf16x8, fr_), bp, ot[t]); }
    }
    const float inv = 1.f / l;
#pragma unroll
    for (int r = 0; r < 4; ++r) { const int e0 = 32 * fq + 8 * r;
        const v4u ag = *(const GAS v4u*)(qrow + C_AG + 128 * h + e0);
        float o[8];
#pragma unroll
        for (int t = 0; t < 8; ++t) o[t] = ot[t][r] * inv * silu_f(bfel(ag, t));
        v4u ow; ow.x = pkbf(o[0], o[1]); ow.y = pkbf(o[2], o[3]); ow.z = pkbf(o[4], o[5]); ow.w = pkbf(o[6], o[7]);
        *(GAS v4u*)(mix + (size_t)(tok0 + n_) * MIXW + MX_AO + 128 * h + e0) = ow; }
}

constexpr int NU1 = 144 + 512 + 128, NU2 = (1024 + 4096) / 8, NU3 = 512 + 128, N_ATT_TASKS = (MTOK * 4) / 16, N_ATT_UNITS = N_ATT_TASKS / 8;
static_assert(N_ATT_TASKS == 4224 && N_ATT_UNITS == 528, "unit list");
struct Args { const float* in[16]; float* out; unsigned char* ws; };
#ifndef REP_P0
#define REP_P0 1
#endif
#ifndef REP_P1
#define REP_P1 1
#endif
#ifndef REP_P2
#define REP_P2 1
#endif
#ifndef REP_P3
#define REP_P3 1
#endif

__global__ void __launch_bounds__(NWAVES * 64, 2) fwd_megakernel(Args args) {
    extern __shared__ __attribute__((aligned(16))) unsigned char lds_raw[];
    LAS unsigned char* lds = (LAS unsigned char*)lds_raw;
    volatile LAS unsigned* MISC = (volatile LAS unsigned*)(lds + MISC_OFF);
    const int tid0 = threadIdx.x, wave = __builtin_amdgcn_readfirstlane(tid0 >> 6);
    const int G = gridDim.x, bx = blockIdx.x, vcu = (G % 8 == 0) ? (bx % 8) * (G / 8) + bx / 8 : bx;
    const int gw = vcu * NWAVES + wave, NGW = G * NWAVES;
    Ptrs P;
    P.x_prompt = args.in[0]; P.x_sample = args.in[1]; P.mem_prompt = args.in[2]; P.state_ret = args.in[3]; P.cache_k = args.in[4]; P.cache_v = args.in[5];
    P.g_norm = args.in[6]; P.w_in = args.in[7]; P.g_ret = args.in[8]; P.g_gmlp = args.in[9]; P.w_s = args.in[10]; P.b_s = args.in[11]; P.g_mem = args.in[12];
    P.w_mem_kv = args.in[13]; P.w_out = args.in[14]; P.g_final = args.in[15]; P.out = args.out; P.ws = args.ws;
    gu32* ctl = (gu32*)(P.ws + WS_CTL);
    bf16* const WINT = (bf16*)(P.ws + WS_WINT); bf16* const WOUTT = (bf16*)(P.ws + WS_WOUTT); bf16* const XN = (bf16*)(P.ws + WS_XN);
    bf16* const PROJ = (bf16*)(P.ws + WS_PROJ); bf16* const MIX = (bf16*)(P.ws + WS_MIX); bf16* const MKV = (bf16*)(P.ws + WS_MKV);
    bf16* const CK = (bf16*)(P.ws + WS_CK); bf16* const CV = (bf16*)(P.ws + WS_CV);
    float* const UBUF = (float*)(P.ws + WS_U); bf16* const STB = (bf16*)(P.ws + WS_ST); bf16* const STSB = (bf16*)(P.ws + WS_STS);
    const float* const ROPE = (const float*)(P.ws + WS_ROPE); float* const SSQ = (float*)(P.ws + WS_SSQ); const bf16* const WTRIL = (const bf16*)(P.ws + WS_WTRIL);

    for (int u = tid0; u < (LDS_BYTES - LDSCTL_OFF) / 4; u += NWAVES * 64) ((LAS unsigned*)(lds + LDSCTL_OFF))[u] = 0u;
    __syncthreads();
    XcdBarrier bar = xcd_barrier_post((unsigned*)(ctl + CW_BAR), MISC + 8);

#ifndef SKIP_P0
    for (int rep = 0; rep < REP_P0; ++rep) { int l0 = tid0 & 63; asm volatile("" : "+v"(l0)); p0_prologue(P, lds, gw, NGW, wave, l0); }
#endif
    xcd_barrier(bar);

#ifndef SKIP_P1
    for (int rep = 0; rep < REP_P1; ++rep) {
        pg8::Gemm g{XN, WINT, MTOK + NMEM, INW + KVW, DM}; pg8::Order1 S; S.init(G, bx);
        pg8::EpiProj E{PROJ, P.out + O_MK, P.out + O_MV, MKV, ROPE};
        pg8::gemm_phase<pg8::EpiProj, pg8::Order1, true, true>(lds, g, S, E);
    }
#endif
    xcd_barrier(bar);

    static_assert(R2_END <= LDSCTL_OFF, "retention LDS");
    for (int rep = 0; rep < REP_P2; ++rep)
#pragma unroll 1
    for (int ph = 0; ph < 3; ++ph) {
        const int NU = ph == 0 ? NU1 : (ph == 1 ? NU2 : NU3);
        gu32* qh = ctl + (ph == 0 ? CW_Q1 : (ph == 1 ? CW_Q2 : CW_Q3)) + 512 * rep; gu32* dn = ctl + (ph == 0 ? CW_D1 : CW_D2) + 512 * rep; gu32* ah = ctl + CW_ATT + 512 * rep;
        bool prev_phase_unit = false;
#pragma unroll 1
        for (;;) {
            __syncthreads();
            if (tid0 == 0) {
                if (prev_phase_unit) __hip_atomic_fetch_add(dn, 1u, RLX_AGENT);
                int code; const unsigned u = __hip_atomic_fetch_add(qh, 1u, RLX_AGENT);
                if (u < (unsigned)NU) code = (int)u;
                else if (ph < 2 && __hip_atomic_load(dn, RLX_AGENT) >= (unsigned)NU) code = -1;
                else { const unsigned a = __hip_atomic_fetch_add(ah, 1u, RLX_AGENT); code = a < (unsigned)N_ATT_UNITS ? NU + (int)a : -1; }
                MISC[0] = (unsigned)code;
            }
            __syncthreads();
            const int u = (int)MISC[0];
            if (u < 0) break;
            prev_phase_unit = u < NU;
            int tid = threadIdx.x; asm volatile("" : "+v"(tid)); const int lane = tid & 63;
            if (u >= NU) { const int t = (u - NU) * 8 + wave; const bool smp = t >= 4096;
                const int t2 = t - 4096, sb = smp ? t2 >> 3 : t >> 10, h = smp ? (t2 >> 1) & 3 : (t >> 8) & 3, qt = smp ? t2 & 1 : t & 255;
                const bf16* Kp = smp ? CK + (size_t)sb * MEMLEN * 512 + 128 * h : MKV + (size_t)sb * MEMLEN * 1024 + 128 * h;
                const bf16* Vp = smp ? CV + (size_t)sb * MEMLEN * 512 + 128 * h : MKV + (size_t)sb * MEMLEN * 1024 + 512 + 128 * h;
                attn_task(PROJ, MIX, Kp, Vp, smp ? 512 : 1024, smp ? TP + sb * DECL + 16 * qt : sb * SEQ + 16 * qt, h, lane);
            } else if (ph == 0) {
                if (u < 144) { const bool smp = u >= 128; const int c = smp ? u - 128 : u;
                    gmlp_unit(lds, PROJ, MIX, WTRIL, P.b_s, P.g_gmlp, smp ? P.out + O_GVS + (size_t)c * DECL * 512 : nullptr, smp ? TP + c * DECL : c * 128, smp ? DECL : 128, tid);
                } else { const int v = u - 144; const bool smp = v >= 512; const int sh = v - 512, bh = v >> 4, m = v & 15, h = smp ? sh & 7 : bh & 7;
                    retA_unit(lds, PROJ, smp ? TP + (sh >> 3) * DECL : (bh >> 3) * SEQ + m * 256, smp ? DECL : 256, h, smp ? P.state_ret + (size_t)sh * 16384 : nullptr,
                              smp ? P.out + O_SRS + (size_t)sh * 16384 : UBUF + (size_t)v * 16384, tid); }
            } else if (ph == 1) {
                retB_item(UBUF, STB, P.state_ret, STSB, P.out + O_SRP, u * 8 + wave, lane);
            } else { const bool smp = u >= 512; const int sh = u - 512, bh = u >> 4, m = u & 15, h = smp ? sh & 7 : bh & 7;
                retC_unit(lds, PROJ, MIX, smp ? STSB + (size_t)sh * 16384 : STB + (size_t)u * 16384, P.g_ret, smp ? TP + (sh >> 3) * DECL : (bh >> 3) * SEQ + m * 256, smp ? DECL : 256, h, tid);
            }
        }
        xcd_barrier(bar);
    }

#ifndef SKIP_P3
    for (int rep = 0; rep < REP_P3; ++rep) {
        pg8::Gemm g{MIX, WOUTT, MTOK, DM, DM}; pg8::StaticOrder S; S.init(MTOK, DM, G, bx);
        pg8::EpiOut E{P.x_prompt, P.x_sample, P.out + O_Y, SSQ};
        pg8::gemm_phase<pg8::EpiOut, pg8::StaticOrder, true, true>(lds, g, S, E);
    }
#endif
    xcd_barrier(bar);

    int lane4 = tid0 & 63; asm volatile("" : "+v"(lane4));
    for (int row = gw; row < MTOK; row += NGW) { const int lane = lane4;
        const float p = lane < 32 ? SSQ[(size_t)row * 32 + lane] : 0.f;
        const float rstd = 1.f / sqrtf(wave_sum(p) * (1.f / DM) + EPS);
        GAS f32x4* o = (GAS f32x4*)(P.out + O_Y + (size_t)row * DM) + lane; const GAS f32x4* gf = (const GAS f32x4*)P.g_final + lane;
#pragma unroll
        for (int j = 0; j < 8; ++j) { const f32x4 v = o[64 * j], gg = gf[64 * j]; o[64 * j] = v * rstd * gg; }
    }
}

extern "C" void kernel_launch(void* const* d_in, const int* in_sizes, int n_in, void* d_out, int out_size, void* d_ws, size_t ws_size, hipStream_t stream) {
    static int grid = 0;
    if (grid == 0) {
        if (n_in != 16 || in_sizes[0] != TP * DM || (size_t)out_size != O_END || ws_size < WS_END) {
            fprintf(stderr, "kernel_launch: unexpected shapes (n_in %d in0 %d out %d ws %zu); nothing launched\n", n_in, n_in > 0 ? in_sizes[0] : -1, out_size, ws_size); grid = -1; return; }
        int dev = 0, cus = 0, per_cu = 0;
        if (hipGetDevice(&dev) != hipSuccess || hipDeviceGetAttribute(&cus, hipDeviceAttributeMultiprocessorCount, dev) != hipSuccess) { fprintf(stderr, "kernel_launch: device query failed\n"); grid = -1; return; }
        if (hipFuncSetAttribute((const void*)fwd_megakernel, hipFuncAttributeMaxDynamicSharedMemorySize, LDS_BYTES) != hipSuccess) { fprintf(stderr, "kernel_launch: hipFuncSetAttribute failed\n"); grid = -1; return; }
        if (hipOccupancyMaxActiveBlocksPerMultiprocessor(&per_cu, (const void*)fwd_megakernel, NWAVES * 64, LDS_BYTES) != hipSuccess || per_cu < 1) {
            fprintf(stderr, "kernel_launch: occupancy query reports %d workgroups per CU\n", per_cu); (void)hipGetLastError(); per_cu = 1; }
        grid = cus;
    }
    if (grid < 0) return;
    if (hipMemsetAsync((char*)d_ws + WS_CTL, 0, CTL_ZERO_BYTES, stream) != hipSuccess) { fprintf(stderr, "kernel_launch: memset failed\n"); return; }
    Args a{};
    for (int i = 0; i < 16; ++i) a.in[i] = (const float*)d_in[i];
    a.out = (float*)d_out; a.ws = (unsigned char*)d_ws;
    hipLaunchKernelGGL(fwd_megakernel, dim3(grid), dim3(NWAVES * 64), LDS_BYTES, stream, a);
    const hipError_t le = hipPeekAtLastError();
    if (le != hipSuccess) fprintf(stderr, "kernel_launch: launch failed: %s\n", hipGetErrorName(le));
}
```

```cpp
#include <hip/hip_runtime.h>
#include <cstdio>
#include <cstdint>
namespace pg8 {
#define PG8_LAS __attribute__((address_space(3)))
typedef unsigned short bf16_t;
typedef short bf16x8 __attribute__((ext_vector_type(8)));
typedef float f32x4 __attribute__((ext_vector_type(4)));
typedef unsigned u32x4 __attribute__((ext_vector_type(4)));
constexpr int BM = 256, BK = 64, HALF = 128, HTB = HALF * BK * 2  , STAGE_BYTES = 8 * HTB, NXCD = 8, WGM = 8;

__host__ __device__ __forceinline__ int lds_byte(int r, int c) { const int st = (r >> 4) * 2 + (c >> 5), rr = r & 15, cc = c & 31, ob = rr * 64 + cc * 2; return st * 1024 + (ob ^ (((ob >> 9) & 1) << 5)); }
__host__ __device__ __forceinline__ void stage_rc(int b, int& R, int& C) { const int st = b / 1024, sb = b % 1024, swz = sb ^ (((sb >> 9) & 1) << 5); R = (st >> 1) * 16 + swz / 64; C = (st & 1) * 32 + (swz % 64) / 2; }
__host__ __device__ __forceinline__ int perm32(int rho) { const int n = rho >> 4, i = rho & 15; return 8 * (i >> 2) + 4 * n + (i & 3); }

struct Unit { int pm, pn; };
struct Gemm { const bf16_t* A; const bf16_t* Bt; int M, N, K; };

struct StaticOrder {
    int nM, nN, nwg, G, c;
    __host__ __device__ void init(int M, int N, int G_, int c_) { nM = M / BM; nN = N / BM; nwg = nM * nN; G = G_; c = c_; }
    __host__ __device__ bool next(int i, Unit& u) const {
        const long L = (long)i * G + c; if (L >= nwg) return false;
        int wgid = (int)L; { const int q = nwg / NXCD, r = nwg % NXCD, xcd = wgid % NXCD, off = wgid / NXCD; wgid = (xcd < r ? xcd * (q + 1) : r * (q + 1) + (xcd - r) * q) + off; }
        const int nig = WGM * nN, gid = wgid / nig, fm = gid * WGM, gsz = (nM - fm) < WGM ? (nM - fm) : WGM;
        u.pm = fm + ((wgid % nig) % gsz); u.pn = (wgid % nig) / gsz; return true;
    }
    __device__ __forceinline__ void a_ready(const Unit&) const {}
    __device__ __forceinline__ void done(const Unit&) const {}
};
__device__ __forceinline__ unsigned cvt_pk_bf16(float lo, float hi) { unsigned r; asm volatile("v_cvt_pk_bf16_f32 %0, %1, %2" : "=v"(r) : "v"(lo), "v"(hi)); return r; }
typedef float f32x2 __attribute__((ext_vector_type(2)));

struct Order1 {
    StaticOrder so; int G, c;
    __device__ void init(int G_, int c_) { so.init(16896, 6656, G_, c_); G = G_; c = c_; }
    __device__ bool next(int i, Unit& u) const {
        if (so.next(i, u)) return true;
        const long L = (long)i * G + c - so.nwg; if (L < 0 || L >= 16) return false;
        u.pm = 66 + (int)(L >> 2); u.pn = 26 + (int)(L & 3); return true;
    }
    __device__ __forceinline__ void a_ready(const Unit&) const {}
    __device__ __forceinline__ void done(const Unit&) const {}
};
struct EpiProj {
    static constexpr bool PERM = true, AFTER_DRAIN = false;
    bf16_t* proj; float* out_mk; float* out_mv; bf16_t* mkv; const float* rope;
    __device__ static __forceinline__ bool rope_unit(const Unit& u) { return u.pn < 8 && u.pm < 66; }
    __device__ __forceinline__ void operator()(const f32x4 (&acc)[2][2][4][2], const Unit& u, int wr, int wc, int fr, int fq) const {
        if (u.pm < 66 && u.pn < 8) {
            const bool isk = u.pn >= 4; const int hb = 2 * (u.pn & 3);
            float lg[2];
#pragma unroll
            for (int bj = 0; bj < 2; ++bj) lg[bj] = log2f(1.0f - exp2f(-5.0f - (float)(hb + bj)));
#pragma unroll
            for (int ai = 0; ai < 2; ++ai)
#pragma unroll
                for (int m = 0; m < 4; ++m) { const int row = u.pm * BM + ai * HALF + wr * 64 + m * 16 + fr;
                    const bool smp = row >= 16384; const int p = smp ? 4096 + ((row - 16384) & 31) : (row & 4095), tl = smp ? ((row - 16384) & 31) : (row & 255);
                    const float* tp = rope + ((size_t)p * 64 + 16 * wc + 4 * fq) * 2; const f32x4 t0 = *(const f32x4*)tp, t1 = *(const f32x4*)(tp + 4);
                    const float cs_[4] = {t0[0], t0[2], t1[0], t1[2]}, sn_[4] = {t0[1], t0[3], t1[1], t1[3]};
                    bf16_t* rowp = proj + (size_t)row * 6656 + u.pn * BM + 16 * wc + 4 * fq;
#pragma unroll
                    for (int bj = 0; bj < 2; ++bj) { const f32x4 x1 = acc[ai][bj][m][0], x2 = acc[ai][bj][m][1];
                        const float fac = isk ? 0.08838834764831845f * __builtin_amdgcn_exp2f(-lg[bj] * (float)tl) : __builtin_amdgcn_exp2f(lg[bj] * (float)tl);
                        float o1[4], o2[4];
#pragma unroll
                        for (int e = 0; e < 4; ++e) { o1[e] = (x1[e] * cs_[e] - x2[e] * sn_[e]) * fac; o2[e] = (x1[e] * sn_[e] + x2[e] * cs_[e]) * fac; }
                        typedef unsigned u32x2 __attribute__((ext_vector_type(2)));
                        u32x2 w1, w2; w1.x = cvt_pk_bf16(o1[0], o1[1]); w1.y = cvt_pk_bf16(o1[2], o1[3]); w2.x = cvt_pk_bf16(o2[0], o2[1]); w2.y = cvt_pk_bf16(o2[2], o2[3]);
                        *(u32x2*)(rowp + bj * HALF) = w1; *(u32x2*)(rowp + bj * HALF + 64) = w2; } }
        } else if (u.pm < 66) {
            typedef unsigned u32x2 __attribute__((ext_vector_type(2)));
            const int row0 = u.pm * BM + wr * 64 + fr, col0 = u.pn * BM + 16 * wc + 4 * fq;
#pragma unroll
            for (int ai = 0; ai < 2; ++ai)
#pragma unroll
                for (int m = 0; m < 4; ++m) { bf16_t* rowp = proj + (size_t)(row0 + ai * HALF + m * 16) * 6656 + col0;
#pragma unroll
                    for (int bj = 0; bj < 2; ++bj) { const f32x4 v0 = acc[ai][bj][m][0], v1 = acc[ai][bj][m][1];
                        u32x2 w1, w2; w1.x = cvt_pk_bf16(v0[0], v0[1]); w1.y = cvt_pk_bf16(v0[2], v0[3]); w2.x = cvt_pk_bf16(v1[0], v1[1]); w2.y = cvt_pk_bf16(v1[2], v1[3]);
                        *(u32x2*)(rowp + bj * HALF) = w1; *(u32x2*)(rowp + bj * HALF + 64) = w2; } }
        } else {
            typedef unsigned u32x2 __attribute__((ext_vector_type(2)));
            const int row0 = (u.pm - 66) * BM + wr * 64 + fr, col0 = (u.pn - 26) * BM + 16 * wc + 4 * fq;
            float* const dst0 = (u.pn - 26) < 2 ? out_mk : out_mv; const int cbase = col0 & 511;
#pragma unroll
            for (int ai = 0; ai < 2; ++ai)
#pragma unroll
                for (int m = 0; m < 4; ++m) { const int row = row0 + ai * HALF + m * 16;
#pragma unroll
                    for (int bj = 0; bj < 2; ++bj) { const f32x4 v0 = acc[ai][bj][m][0], v1 = acc[ai][bj][m][1];
                        float* d = dst0 + (size_t)row * 512 + cbase + bj * HALF; *(f32x4*)d = v0; *(f32x4*)(d + 64) = v1;
                        u32x2 w1, w2; w1.x = cvt_pk_bf16(v0[0], v0[1]); w1.y = cvt_pk_bf16(v0[2], v0[3]); w2.x = cvt_pk_bf16(v1[0], v1[1]); w2.y = cvt_pk_bf16(v1[2], v1[3]);
                        bf16_t* q = mkv + (size_t)row * 1024 + col0 + bj * HALF; *(u32x2*)q = w1; *(u32x2*)(q + 64) = w2; } }
        }
    }
};
struct EpiOut {
    static constexpr bool PERM = false, AFTER_DRAIN = false;
    __device__ static __forceinline__ bool rope_unit(const Unit&) { return false; }
    const float* xp; const float* xs; float* out; float* ssq;
    __device__ __forceinline__ void operator()(const f32x4 (&acc)[2][2][4][2], const Unit& u, int wr, int wc, int fr, int fq) const {
        const int col0 = u.pn * BM + wc * 32 + 4 * fq;
#pragma unroll
        for (int ai = 0; ai < 2; ++ai)
#pragma unroll
            for (int m = 0; m < 4; ++m) { const int row = u.pm * BM + ai * HALF + wr * 64 + m * 16 + fr;
                const float* xrow = row < 16384 ? xp + (size_t)row * 2048 : xs + (size_t)(row - 16384) * 2048; float* orow = out + (size_t)row * 2048; float s = 0.f;
#pragma unroll
                for (int bj = 0; bj < 2; ++bj)
#pragma unroll
                    for (int n = 0; n < 2; ++n) { const int c = col0 + bj * HALF + n * 16; const f32x4 o = *(const f32x4*)(xrow + c) + acc[ai][bj][m][n]; *(f32x4*)(orow + c) = o;
                        s += (o[0] * o[0] + o[1] * o[1]) + (o[2] * o[2] + o[3] * o[3]); }
                s += __shfl_xor(s, 16); s += __shfl_xor(s, 32);
                if (fq == 0) ssq[(size_t)row * 32 + u.pn * 4 + wc] = s;
                if (m & 1) asm volatile("" ::: "memory"); }
    }
};
template <class Epi, class Sched, bool ALIGN_EPI = false, bool SP2 = false>
__device__ __forceinline__ void gemm_phase(PG8_LAS unsigned char* lds, const Gemm g, const Sched& S, const Epi& E) {
    int tid_ = threadIdx.x; asm volatile("" : "+v"(tid_));
    const int tid = tid_, wid = __builtin_amdgcn_readfirstlane(tid >> 6), lane = tid & 63, wr = wid >> 2, wc = wid & 3, fr = lane & 15, fq = lane >> 4;
    const int K = g.K, nt = K / BK;
    unsigned voffA[2], voffB[2];
#pragma unroll
    for (int i = 0; i < 2; ++i) { int R, C; stage_rc(tid * 16 + i * 8192, R, C); const int Rb = Epi::PERM ? (64 * ((R >> 4) & 1) + 16 * (R >> 5) + (R & 15)) : R;
        voffA[i] = (unsigned)(R * K + C) * 2u; voffB[i] = (unsigned)(Rb * K + C) * 2u; }
    const size_t kstep = (size_t)(BK * 2);
    const size_t hstep = (size_t)HALF * K * 2;
    const size_t tstep = 2 * hstep;
    const unsigned ldsw = (unsigned)wid * 1024u;
    const int aoff = lds_byte(wr * 64 + fr, fq * 8), boff = lds_byte(wc * 32 + fr, fq * 8);
#define PG8_SA(b, h) (((b) * 2 + (h)) * HTB)
#define PG8_SB(b, h) ((4 + (b) * 2 + (h)) * HTB)
#define PG8_STAGE(bufoff, gbase, voff) do { _Pragma("unroll") for (int _i = 0; _i < 2; ++_i) \
        __builtin_amdgcn_global_load_lds((const unsigned*)((const char*)(gbase) + (voff)[_i]), (PG8_LAS unsigned*)(lds + (bufoff) + ldsw + _i * 8192), 16, 0, 0); } while (0)
#define PG8_LDA(dst, b, h) do { _Pragma("unroll") for (int m = 0; m < 4; ++m) _Pragma("unroll") for (int k = 0; k < 2; ++k) dst[m][k] = *(const PG8_LAS bf16x8*)(lds + PG8_SA(b, h) + aoff + m * 2048 + k * 1024); } while (0)
#define PG8_LDB(dst, b, h) do { _Pragma("unroll") for (int n = 0; n < 2; ++n) _Pragma("unroll") for (int k = 0; k < 2; ++k) dst[n][k] = *(const PG8_LAS bf16x8*)(lds + PG8_SB(b, h) + boff + n * 2048 + k * 1024); } while (0)
#define PG8_MMA(ai, bj, At, Bt) do { __builtin_amdgcn_s_setprio(1); _Pragma("unroll") for (int m = 0; m < 4; ++m) _Pragma("unroll") for (int n = 0; n < 2; ++n) _Pragma("unroll") for (int k = 0; k < 2; ++k) \
        acc[ai][bj][m][n] = __builtin_amdgcn_mfma_f32_16x16x32_bf16(Bt[n][k], At[m][k], acc[ai][bj][m][n], 0, 0, 0); __builtin_amdgcn_s_setprio(0); } while (0)
#define PG8_WAIT_V(n) asm volatile("s_waitcnt vmcnt(" #n ")" ::: "memory")
#define PG8_WAIT_L(n) asm volatile("s_waitcnt lgkmcnt(" #n ")" ::: "memory")
#define PG8_BAR __builtin_amdgcn_s_barrier()
#define PG8_SCHED __builtin_amdgcn_sched_barrier(0)
    Unit cur, nxt; int ui = 0;
    if (!S.next(0, cur)) return;
    f32x4 acc[2][2][4][2];
#pragma unroll
    for (int a = 0; a < 2; ++a)
#pragma unroll
        for (int b = 0; b < 2; ++b)
#pragma unroll
            for (int m = 0; m < 4; ++m)
#pragma unroll
                for (int n = 0; n < 2; ++n) acc[a][b][m][n] = (f32x4){0.f, 0.f, 0.f, 0.f};
    bf16x8 At[4][2], B0[2][2], B1[2][2];
    const char* cA = (const char*)g.A + (size_t)cur.pm * tstep; const char* cB = (const char*)g.Bt + (size_t)cur.pn * tstep;
    S.a_ready(cur);
    if constexpr (SP2) {
        PG8_STAGE(PG8_SB(0, 0), cB, voffB); PG8_STAGE(PG8_SB(0, 1), cB + hstep, voffB); PG8_STAGE(PG8_SA(0, 0), cA, voffA); PG8_STAGE(PG8_SA(0, 1), cA + hstep, voffA);
        if (wr == 1) PG8_BAR;
        PG8_WAIT_V(2); PG8_BAR;
        PG8_STAGE(PG8_SB(1, 0), cB + kstep, voffB); PG8_STAGE(PG8_SA(1, 0), cA + kstep, voffA); PG8_STAGE(PG8_SB(1, 1), cB + hstep + kstep, voffB);
        PG8_WAIT_V(6); PG8_BAR;
    } else {
        PG8_STAGE(PG8_SB(0, 0), cB, voffB); PG8_STAGE(PG8_SA(0, 0), cA, voffA); PG8_STAGE(PG8_SB(0, 1), cB + hstep, voffB); PG8_STAGE(PG8_SA(0, 1), cA + hstep, voffA);
        if (wr == 1) PG8_BAR;
        PG8_WAIT_V(4); PG8_BAR;
        PG8_STAGE(PG8_SB(1, 0), cB + kstep, voffB); PG8_STAGE(PG8_SA(1, 0), cA + kstep, voffA); PG8_STAGE(PG8_SB(1, 1), cB + hstep + kstep, voffB);
        PG8_WAIT_V(6); PG8_BAR;
    }
    for (;;) {
        const bool has_next = S.next(ui + 1, nxt);
        const char* nA = has_next ? (const char*)g.A + (size_t)nxt.pm * tstep : cA; const char* nB = has_next ? (const char*)g.Bt + (size_t)nxt.pn * tstep : cB;
        for (int t = 0; t < nt; t += 2) {
            const bool last = (t == nt - 2);
            const char* a1 = cA + (size_t)(t + 1) * kstep;
            const char* a2 = last ? nA : cA + (size_t)(t + 2) * kstep; const char* b2 = last ? nB : cB + (size_t)(t + 2) * kstep;
            const char* a3 = a2 + kstep; const char* b3 = b2 + kstep;
            if (last && has_next) S.a_ready(nxt);
            if constexpr (SP2) {
            PG8_LDB(B0, 0, 0); PG8_LDB(B1, 0, 1); PG8_SCHED; PG8_LDA(At, 0, 0); PG8_STAGE(PG8_SA(1, 1), a1 + hstep, voffA);
            PG8_WAIT_V(8); PG8_WAIT_L(0); PG8_BAR; PG8_MMA(0, 0, At, B0); PG8_MMA(0, 1, At, B1); PG8_BAR; PG8_SCHED;
            PG8_LDA(At, 0, 1); PG8_STAGE(PG8_SB(0, 0), b2, voffB); PG8_STAGE(PG8_SB(0, 1), b2 + hstep, voffB); PG8_STAGE(PG8_SA(0, 0), a2, voffA);
            PG8_WAIT_V(8); PG8_WAIT_L(0); PG8_BAR; PG8_MMA(1, 0, At, B0); PG8_MMA(1, 1, At, B1); PG8_BAR; PG8_SCHED;
            PG8_LDB(B0, 1, 0); PG8_LDB(B1, 1, 1); PG8_SCHED; PG8_LDA(At, 1, 0); PG8_STAGE(PG8_SA(0, 1), a2 + hstep, voffA);
            PG8_WAIT_V(8); PG8_WAIT_L(0); PG8_BAR; PG8_MMA(0, 0, At, B0); PG8_MMA(0, 1, At, B1); PG8_BAR; PG8_SCHED;
            PG8_LDA(At, 1, 1); PG8_STAGE(PG8_SB(1, 0), b3, voffB); PG8_STAGE(PG8_SB(1, 1), b3 + hstep, voffB); PG8_STAGE(PG8_SA(1, 0), a3, voffA);
            PG8_WAIT_V(8); PG8_WAIT_L(0); PG8_BAR; PG8_MMA(1, 0, At, B0); PG8_MMA(1, 1, At, B1); PG8_BAR; PG8_SCHED;
            } else {
            PG8_LDB(B0, 0, 0); PG8_SCHED; PG8_LDA(At, 0, 0); PG8_STAGE(PG8_SA(1, 1), a1 + hstep, voffA);
            PG8_WAIT_L(8); PG8_BAR; PG8_WAIT_L(0); PG8_MMA(0, 0, At, B0); PG8_BAR; PG8_SCHED;
            PG8_LDB(B1, 0, 1); PG8_STAGE(PG8_SB(0, 0), b2, voffB);
            PG8_BAR; PG8_WAIT_L(0); PG8_MMA(0, 1, At, B1); PG8_BAR;
            PG8_LDA(At, 0, 1); PG8_STAGE(PG8_SA(0, 0), a2, voffA);
            PG8_BAR; PG8_WAIT_L(0); PG8_MMA(1, 0, At, B0); PG8_BAR; PG8_SCHED;
            PG8_STAGE(PG8_SB(0, 1), b2 + hstep, voffB);
            PG8_WAIT_V(6); PG8_BAR; PG8_MMA(1, 1, At, B1); PG8_BAR;
            PG8_LDB(B0, 1, 0); PG8_SCHED; PG8_LDA(At, 1, 0); PG8_STAGE(PG8_SA(0, 1), a2 + hstep, voffA);
            PG8_WAIT_L(8); PG8_BAR; PG8_WAIT_L(0); PG8_MMA(0, 0, At, B0); PG8_BAR; PG8_SCHED;
            PG8_LDB(B1, 1, 1); PG8_STAGE(PG8_SB(1, 0), b3, voffB);
            PG8_BAR; PG8_WAIT_L(0); PG8_MMA(0, 1, At, B1); PG8_BAR;
            PG8_LDA(At, 1, 1); PG8_STAGE(PG8_SA(1, 0), a3, voffA);
            PG8_BAR; PG8_WAIT_L(0); PG8_MMA(1, 0, At, B0); PG8_BAR; PG8_SCHED;
            PG8_STAGE(PG8_SB(1, 1), b3 + hstep, voffB);
            PG8_WAIT_V(6); PG8_BAR; PG8_MMA(1, 1, At, B1); PG8_BAR;
            }
        }
        if constexpr (ALIGN_EPI) { if (wr == 0) PG8_BAR; }
        if constexpr (!Epi::AFTER_DRAIN) { E(acc, cur, wr, wc, fr, fq); S.done(cur); }
        if (!has_next) break;
#pragma unroll
        for (int a = 0; a < 2; ++a)
#pragma unroll
            for (int b = 0; b < 2; ++b)
#pragma unroll
                for (int m = 0; m < 4; ++m)
#pragma unroll
                    for (int n = 0; n < 2; ++n) acc[a][b][m][n] = (f32x4){0.f, 0.f, 0.f, 0.f};
        cur = nxt; cA = nA; cB = nB; ++ui;
        if constexpr (ALIGN_EPI) { if (wr == 1) PG8_BAR; }
    }
    PG8_WAIT_V(0);
    if constexpr (!ALIGN_EPI) { if (wr == 0) PG8_BAR; }
    PG8_BAR;
    if constexpr (Epi::AFTER_DRAIN) { E.fused(acc, cur, wr, wc, fr, fq, lds, wid, lane); S.done(cur); }
#undef PG8_SA
#undef PG8_SB
#undef PG8_STAGE
#undef PG8_LDA
#undef PG8_LDB
#undef PG8_MMA
#undef PG8_WAIT_V
#undef PG8_WAIT_L
#undef PG8_BAR
#undef PG8_SCHED
}
}
#define GAS __attribute__((address_space(1)))
#define LAS __attribute__((address_space(3)))
typedef unsigned short bf16;
typedef unsigned v4u __attribute__((ext_vector_type(4)));
typedef float f32x4 __attribute__((ext_vector_type(4)));
typedef short bf16x8 __attribute__((ext_vector_type(8)));
typedef GAS unsigned gu32;
typedef GAS unsigned long long gu64;
#define RLX_AGENT __ATOMIC_RELAXED, __HIP_MEMORY_SCOPE_AGENT
#define LDS_WAIT() asm volatile("s_waitcnt lgkmcnt(0)" ::: "memory")
#define VM_WAIT() asm volatile("s_waitcnt vmcnt(0)" ::: "memory")
__device__ __forceinline__ unsigned long long rt() { return __builtin_amdgcn_s_memrealtime(); }
__device__ __forceinline__ unsigned f2bf(float f) { unsigned u = __builtin_bit_cast(unsigned, f); return (u + 0x7fffu + ((u >> 16) & 1u)) >> 16; }
__device__ __forceinline__ unsigned pk2(float lo, float hi) { return f2bf(lo) | (f2bf(hi) << 16); }

#define XB_TMO      128
#define XB_XCNT(j)  (256  + 64 * (j))
#define XB_XSUB(j)  (1280 + 64 * (j))
#define XB_XGEN(j)  (2304 + 64 * (j))
#define XB_TOP      3328
#define XB_TOPGEN   3392
#define XCD_BAR_WORDS 3456
#define XB_SPIN_CAP (1u << 18)

__device__ __forceinline__ unsigned xb_ld(unsigned* p)              { return __hip_atomic_load(p, __ATOMIC_RELAXED, __HIP_MEMORY_SCOPE_AGENT); }
__device__ __forceinline__ unsigned xb_add(unsigned* p, unsigned v) { return __hip_atomic_fetch_add(p, v, __ATOMIC_RELAXED, __HIP_MEMORY_SCOPE_AGENT); }
__device__ __forceinline__ unsigned xb_xcc_id() { return (unsigned)__builtin_amdgcn_s_getreg((3 << 11) | 20) & 0xFu; }
#define XB_SPIN(cond, bar) do { unsigned _sp = 0; while (cond) { __builtin_amdgcn_s_sleep(1); \
    if ((++_sp & 255u) == 0u) { if (xb_ld(&(bar)[XB_TMO])) break; if (_sp > XB_SPIN_CAP) { atomicAdd(&(bar)[XB_TMO], 1u); break; } } } } while (0)

struct XcdBarrier {
    unsigned* bar; unsigned x;
    volatile LAS unsigned* st;
};

__device__ __forceinline__ XcdBarrier xcd_barrier_post(unsigned* bar, volatile LAS unsigned* st) {
    XcdBarrier b; b.bar = bar; b.x = xb_xcc_id(); b.st = st;
    if (threadIdx.x == 0) (void)xb_add(&bar[XB_XCNT(b.x)], 1u);
    return b;
}
__device__ __forceinline__ void xcd_barrier_complete(unsigned* bar, unsigned x, unsigned& nloc, unsigned& nx) {
    const unsigned G = gridDim.x * gridDim.y * gridDim.z;
    unsigned sum, cnt, mine, sp = 0u;
    for (;;) {
        sum = 0u; cnt = 0u; mine = 0u;
#pragma unroll
        for (unsigned j = 0; j < 16; ++j) { const unsigned c = xb_ld(&bar[XB_XCNT(j)]); sum += c; cnt += (c > 0u) ? 1u : 0u; mine = (j == x) ? c : mine; }
        if (sum == G) break;
        __builtin_amdgcn_s_sleep(1);
        if ((++sp & 255u) == 0u) { if (xb_ld(&bar[XB_TMO])) break; if (sp > XB_SPIN_CAP) { atomicAdd(&bar[XB_TMO], 1u); break; } }
    }
    nloc = mine > 0u ? mine : 1u; nx = cnt > 0u ? cnt : 1u;
}

__device__ __forceinline__ void xcd_barrier(const XcdBarrier& b) {
    asm volatile("s_waitcnt vmcnt(0)" ::: "memory");
    __syncthreads();
    if (threadIdx.x == 0) {
        unsigned* bar = b.bar;
        __builtin_amdgcn_s_waitcnt(0);
        unsigned nloc = b.st[0], nx = b.st[1];
        if (nloc == 0u) { xcd_barrier_complete(bar, b.x, nloc, nx); b.st[0] = nloc; b.st[1] = nx; }
        const unsigned old = xb_add(&bar[XB_XSUB(b.x)], 1u);
        const unsigned gen = old / nloc;
        if (old + 1u == (gen + 1u) * nloc) {
            __builtin_amdgcn_fence(__ATOMIC_RELEASE, "agent");
            asm volatile("s_waitcnt vmcnt(0)" ::: "memory");
            const unsigned og = xb_add(&bar[XB_TOP], 1u);
            const unsigned tg = og / nx;
            if (og + 1u == (tg + 1u) * nx) xb_add(&bar[XB_TOPGEN], 1u);
            else XB_SPIN(xb_ld(&bar[XB_TOPGEN]) == tg, bar);
            __builtin_amdgcn_fence(__ATOMIC_ACQUIRE, "agent");
            xb_add(&bar[XB_XGEN(b.x)], 1u);
            asm volatile("s_waitcnt vmcnt(0)" ::: "memory");
        } else {
            XB_SPIN(xb_ld(&bar[XB_XGEN(b.x)]) == gen, bar);
            __builtin_amdgcn_fence(__ATOMIC_ACQUIRE, "agent");
            asm volatile("s_waitcnt vmcnt(0)" ::: "memory");
        }
    }
    __syncthreads();
}

constexpr int NWAVES = 8;
constexpr int DM = 2048, TP = 16384, TS = 512, MTOK = TP + TS, SEQ = 4096, NBATCH = 4, DECB = 16, DECL = 32, PAST = 1024, MEMLEN = 256, NMEM = NBATCH * MEMLEN;
constexpr int INW = 6656, KVW = 1024;
constexpr int C_RQ = 0, C_RK = 1024, C_RV = 2048, C_RG = 3072, C_GU = 4096, C_GV = 4608, C_GG = 5120, C_AQ = 5632, C_AG = 6144;
constexpr int MIXW = 2048, MX_RO = 0, MX_GO = 1024, MX_AO = 1536;
constexpr float EPS = 1e-6f;
constexpr size_t O_Y = 0, O_SRP = (size_t)MTOK * DM, O_MK = O_SRP + 4 * 8 * 128 * 128, O_MV = O_MK + (size_t)NMEM * 512, O_SRS = O_MV + (size_t)NMEM * 512,
                 O_GVS = O_SRS + (size_t)DECB * 8 * 128 * 128, O_END = O_GVS + (size_t)DECB * DECL * 512;
static_assert(O_END == 38535168, "d_out size");
constexpr size_t MiB = 1u << 20;
constexpr size_t WS_CTL = 0, CTL_ZERO_BYTES = 1 * MiB;
constexpr size_t WS_WINT = 2 * MiB;
constexpr size_t WS_WOUTT = 32 * MiB;
constexpr size_t WS_XN = 40 * MiB;
constexpr size_t WS_PROJ = 112 * MiB;
constexpr size_t WS_MIX = 328 * MiB;
constexpr size_t WS_MKV = 394 * MiB;
constexpr size_t WS_CK = 396 * MiB, WS_CV = 400 * MiB;
constexpr size_t WS_ROPE = 404 * MiB;
constexpr size_t WS_SSQ = 407 * MiB;
constexpr size_t WS_WTRIL = 410 * MiB;
constexpr size_t WS_U = 412 * MiB;
constexpr size_t WS_ST = 444 * MiB;
constexpr size_t WS_STS = 460 * MiB;
constexpr size_t WS_END = 464 * MiB;
constexpr int CW_BAR = 4096;
constexpr int CW_Q1 = 64, CW_Q2 = 128, CW_Q3 = 192, CW_D1 = 256, CW_D2 = 320, CW_ATT = 384;
constexpr int RING_BYTES = 131072, LDS_BYTES = 147456, LDSCTL_OFF = LDS_BYTES - 512, MISC_OFF = LDSCTL_OFF + 320;
static_assert(MISC_OFF + 128 <= LDS_BYTES, "LDS map");

__device__ const float INV_FREQ[64] = {
1.000000000e+00f, 8.659643531e-01f, 7.498942018e-01f, 6.493816376e-01f, 5.623413324e-01f, 4.869675338e-01f, 4.216965139e-01f, 3.651741147e-01f,
3.162277639e-01f, 2.738419771e-01f, 2.371373773e-01f, 2.053525001e-01f, 1.778279394e-01f, 1.539926529e-01f, 1.333521456e-01f, 1.154781953e-01f,
1.000000015e-01f, 8.659642935e-02f, 7.498942316e-02f, 6.493816525e-02f, 5.623413250e-02f, 4.869675264e-02f, 4.216964915e-02f, 3.651741147e-02f,
3.162277490e-02f, 2.738419548e-02f, 2.371373773e-02f, 2.053525113e-02f, 1.778279431e-02f, 1.539926510e-02f, 1.333521400e-02f, 1.154781971e-02f,
9.999999776e-03f, 8.659643121e-03f, 7.498942316e-03f, 6.493816152e-03f, 5.623413250e-03f, 4.869675264e-03f, 4.216964822e-03f, 3.651741194e-03f,
3.162277630e-03f, 2.738419687e-03f, 2.371373819e-03f, 2.053525066e-03f, 1.778279431e-03f, 1.539926510e-03f, 1.333521446e-03f, 1.154782018e-03f,
1.000000047e-03f, 8.659643354e-04f, 7.498941850e-04f, 6.493816036e-04f, 5.623413017e-04f, 4.869675322e-04f, 4.216965172e-04f, 3.651741135e-04f,
3.162277571e-04f, 2.738419571e-04f, 2.371373703e-04f, 2.053525095e-04f, 1.778279402e-04f, 1.539926598e-04f, 1.333521504e-04f, 1.154782003e-04f
};

typedef short s16x4 __attribute__((ext_vector_type(4)));
typedef unsigned u32x2 __attribute__((ext_vector_type(2)));
typedef float f32x2 __attribute__((ext_vector_type(2)));
typedef __bf16 bf16x2_t __attribute__((ext_vector_type(2)));
typedef short v4i16_t __attribute__((ext_vector_type(4)));
__device__ __forceinline__ unsigned pkbf(float lo, float hi) { f32x2 v = {lo, hi}; bf16x2_t b = __builtin_convertvector(v, bf16x2_t); return __builtin_bit_cast(unsigned, b); }
__device__ __forceinline__ float bflo(unsigned w) { return __uint_as_float(w << 16); }
__device__ __forceinline__ float bfhi(unsigned w) { return __uint_as_float(w & 0xffff0000u); }
__device__ __forceinline__ float bfel(const v4u& x, int e) { const unsigned w = x[e >> 1]; return (e & 1) ? bfhi(w) : bflo(w); }
__device__ __forceinline__ float silu_f(float x) { return x * __builtin_amdgcn_rcpf(1.0f + __builtin_amdgcn_exp2f(-1.4426950408889634f * x)); }
__device__ __forceinline__ float wave_sum(float v) {
#pragma unroll
    for (int o = 1; o < 64; o <<= 1) v += __shfl_xor(v, o);
    return v;
}
__device__ __forceinline__ f32x4 mfma16(bf16x8 a, bf16x8 b, f32x4 c) { return __builtin_amdgcn_mfma_f32_16x16x32_bf16(a, b, c, 0, 0, 0); }
__device__ __forceinline__ s16x4 lds_tr(LAS unsigned char* p) { return __builtin_bit_cast(s16x4, __builtin_amdgcn_ds_read_tr16_b64_v4i16((LAS v4i16_t*)p)); }
__device__ __forceinline__ bf16x8 cat8(s16x4 lo, s16x4 hi) { return (bf16x8){lo[0], lo[1], lo[2], lo[3], hi[0], hi[1], hi[2], hi[3]}; }
__device__ __forceinline__ bf16x8 pack8(const f32x4& a, const f32x4& b) { v4u w; w.x = pkbf(a[0], a[1]); w.y = pkbf(a[2], a[3]); w.z = pkbf(b[0], b[1]); w.w = pkbf(b[2], b[3]); return __builtin_bit_cast(bf16x8, w); }

__device__ __forceinline__ void p0_transpose_item(const float* W, int K, int N, bf16* WT, int row_off, LAS float* scr, int item, int lane) {
    const int nblk = N / 32, kb = item / nblk, nb = item % nblk, k0 = 64 * kb, n0 = 32 * nb;
#pragma unroll 8
    for (int i = 0; i < 32; ++i) { const int kk = 2 * i + (lane >> 5); scr[kk * 33 + (lane & 31)] = W[(size_t)(k0 + kk) * N + n0 + (lane & 31)]; }
    LDS_WAIT(); asm volatile("" ::: "memory");
    const int c = lane & 7;
#pragma unroll
    for (int j = 0; j < 4; ++j) { const int n = (lane >> 3) + 8 * j; const LAS float* s = scr + (8 * c) * 33 + n;
        v4u o; o.x = pk2(s[0 * 33], s[1 * 33]); o.y = pk2(s[2 * 33], s[3 * 33]); o.z = pk2(s[4 * 33], s[5 * 33]); o.w = pk2(s[6 * 33], s[7 * 33]);
        *(GAS v4u*)(WT + (size_t)(row_off + n0 + n) * K + k0 + 8 * c) = o; }
    LDS_WAIT(); asm volatile("" ::: "memory");
}
__device__ __forceinline__ void rms_row_to_bf16(const float* xrow, const float* g, bf16* orow, int lane) {
    const GAS f32x4* xr = (const GAS f32x4*)xrow + lane; const GAS f32x4* gr = (const GAS f32x4*)g + lane;
    f32x4 v[8]; float s = 0.f;
#pragma unroll
    for (int j = 0; j < 8; ++j) { v[j] = xr[64 * j]; s += (v[j].x * v[j].x + v[j].y * v[j].y) + (v[j].z * v[j].z + v[j].w * v[j].w); }
    const float rstd = 1.f / sqrtf(wave_sum(s) * (1.f / DM) + EPS);
    GAS unsigned long long* o8 = (GAS unsigned long long*)orow + lane;
#pragma unroll
    for (int j = 0; j < 8; ++j) { const f32x4 gg = gr[64 * j];
        o8[64 * j] = (unsigned long long)pk2(v[j].x * rstd * gg.x, v[j].y * rstd * gg.y) | ((unsigned long long)pk2(v[j].z * rstd * gg.z, v[j].w * rstd * gg.w) << 32); }
}
struct Ptrs {
    const float *x_prompt, *x_sample, *mem_prompt, *state_ret, *cache_k, *cache_v, *g_norm, *w_in, *g_ret, *g_gmlp, *w_s, *b_s, *g_mem, *w_mem_kv, *w_out, *g_final;
    float* out; unsigned char* ws;
};
__device__ __forceinline__ void p0_prologue(const Ptrs& P, LAS unsigned char* lds, int gw, int NGW, int wave, int lane) {
    LAS float* scr = (LAS float*)(lds + wave * 16384);
    bf16* WINT = (bf16*)(P.ws + WS_WINT); bf16* WOUTT = (bf16*)(P.ws + WS_WOUTT); bf16* XN = (bf16*)(P.ws + WS_XN);
    constexpr int I_IN = (DM / 64) * (INW / 32), I_KV = (DM / 64) * (KVW / 32), I_OUT = (DM / 64) * (DM / 32);
    for (int it = gw; it < I_IN + I_KV + I_OUT; it += NGW) {
        int r = it;
        if (r < I_IN) { p0_transpose_item(P.w_in, DM, INW, WINT, 0, scr, r, lane); continue; } r -= I_IN;
        if (r < I_KV) { p0_transpose_item(P.w_mem_kv, DM, KVW, WINT, INW, scr, r, lane); continue; } r -= I_KV;
        p0_transpose_item(P.w_out, DM, DM, WOUTT, 0, scr, r, lane);
    }
    for (int m = gw; m < MTOK + NMEM; m += NGW) {
        const float* xr = m < TP ? P.x_prompt + (size_t)m * DM : (m < MTOK ? P.x_sample + (size_t)(m - TP) * DM : P.mem_prompt + (size_t)(m - MTOK) * DM);
        rms_row_to_bf16(xr, m < MTOK ? P.g_norm : P.g_mem, XN + (size_t)m * DM, lane);
    }
    for (int it = gw; it < 8192; it += NGW) {
        const float* src = (it < 4096 ? P.cache_k : P.cache_v) + (size_t)(it & 4095) * 512 + lane * 8;
        bf16* dst = (bf16*)(P.ws + (it < 4096 ? WS_CK : WS_CV)) + (size_t)(it & 4095) * 512 + lane * 8;
        const f32x4 a = *(const GAS f32x4*)src, b = *(const GAS f32x4*)(src + 4);
        v4u o; o.x = pk2(a.x, a.y); o.y = pk2(a.z, a.w); o.z = pk2(b.x, b.y); o.w = pk2(b.z, b.w); *(GAS v4u*)dst = o;
    }
    for (int p = gw; p < SEQ + DECL; p += NGW) {
        const int pos = p < SEQ ? p : PAST + (p - SEQ);
        const float ang = (float)pos * INV_FREQ[lane];
        const double t = (double)ang * 0.15915494309189535; const float fr = (float)(t - floor(t));
        f32x2 cs; cs.x = __builtin_amdgcn_cosf(fr); cs.y = __builtin_amdgcn_sinf(fr);
        *((GAS f32x2*)(P.ws + WS_ROPE) + (size_t)p * 64 + lane) = cs;
    }
    for (int it = gw; it < 128; it += NGW) {
        const int idx = it * 512 + lane * 8, i = (idx >> 7) & 127, j0 = idx & 127;
        const f32x4 a = *(const GAS f32x4*)(P.w_s + idx), b = *(const GAS f32x4*)(P.w_s + idx + 4);
        float f[8] = {a.x, a.y, a.z, a.w, b.x, b.y, b.z, b.w};
#pragma unroll
        for (int e = 0; e < 8; ++e) f[e] = (j0 + e <= i) ? f[e] : 0.f;
        v4u o; o.x = pk2(f[0], f[1]); o.y = pk2(f[2], f[3]); o.z = pk2(f[4], f[5]); o.w = pk2(f[6], f[7]); *(GAS v4u*)((bf16*)(P.ws + WS_WTRIL) + idx) = o;
    }
}

constexpr int RP = 272, R2_V = 256 * RP, R2_END = 2 * 256 * RP;
__device__ __forceinline__ void ret_load_kv(LAS unsigned char* lds, const bf16* proj, int row0, int nk, int h, int tid) {
    const int c = tid & 15, r0 = tid >> 4;
    if (nk == 256) {
        v4u kx[8], vx[8];
#pragma unroll
        for (int i = 0; i < 8; ++i) { const bf16* pr = proj + (size_t)(row0 + r0 + 32 * i) * INW + 128 * h + 8 * c; kx[i] = *(const GAS v4u*)(pr + C_RK); vx[i] = *(const GAS v4u*)(pr + C_RV); }
#pragma unroll
        for (int i = 0; i < 8; ++i) { LAS unsigned char* d = lds + (r0 + 32 * i) * RP + 16 * c; *(LAS v4u*)d = kx[i]; *(LAS v4u*)(d + R2_V) = vx[i]; }
    } else {
        const bf16* pr = proj + (size_t)(row0 + r0) * INW + 128 * h + 8 * c; const v4u kx = *(const GAS v4u*)(pr + C_RK), vx = *(const GAS v4u*)(pr + C_RV);
        LAS unsigned char* d = lds + r0 * RP + 16 * c; *(LAS v4u*)d = kx; *(LAS v4u*)(d + R2_V) = vx;
    }
}
__device__ __forceinline__ void retA_unit(LAS unsigned char* lds, const bf16* proj, int row0, int nk, int h, const float* S0, float* Uout, int tid) {
    const int lane = tid & 63, w = __builtin_amdgcn_readfirstlane(tid >> 6), n_ = lane & 15, fq = lane >> 4, q_ = n_ >> 2, p_ = lane & 3;
    __syncthreads();
    ret_load_kv(lds, proj, row0, nk, h, tid);
    __syncthreads();
    f32x4 acc[8];
#pragma unroll
    for (int t = 0; t < 8; ++t) acc[t] = (f32x4){0.f, 0.f, 0.f, 0.f};
    const int ns = nk >> 5;
    for (int s = 0; s < ns; ++s) {
        LAS unsigned char* vb = lds + R2_V + (32 * s + 8 * fq + q_) * RP + (16 * w + 4 * p_) * 2; const bf16x8 vf = cat8(lds_tr(vb), lds_tr(vb + 4 * RP));
#pragma unroll
        for (int t = 0; t < 8; ++t) { LAS unsigned char* kb = lds + (32 * s + 8 * fq + q_) * RP + (16 * t + 4 * p_) * 2; acc[t] = mfma16(cat8(lds_tr(kb), lds_tr(kb + 4 * RP)), vf, acc[t]); }
    }
    float a0 = 0.f, a1 = 1.f;
    if (S0) { const float lg2 = log2f(1.0f - exp2f(-5.0f - (float)h)); a0 = __builtin_amdgcn_exp2f(lg2 * 32.f); a1 = __builtin_amdgcn_exp2f(lg2 * 31.f); }
#pragma unroll
    for (int t = 0; t < 8; ++t)
#pragma unroll
        for (int r = 0; r < 4; ++r) { const size_t o = (size_t)(16 * t + 4 * fq + r) * 128 + 16 * w + n_; Uout[o] = S0 ? a0 * S0[o] + a1 * acc[t][r] : acc[t][r]; }
}
__device__ __forceinline__ void retB_item(const float* U, bf16* ST, const float* S0s, bf16* STS, float* Send, int item, int lane) {
    if (item < 1024) {
        const int bh = item >> 5, wv = item & 31, e = (wv & 1) * 64 + lane, d0 = (wv >> 1) * 8, h = bh & 7;
        const float lg2 = log2f(1.0f - exp2f(-5.0f - (float)h)), g256 = __builtin_amdgcn_exp2f(lg2 * 256.f), g255 = __builtin_amdgcn_exp2f(lg2 * 255.f);
        float S[8];
#pragma unroll
        for (int j = 0; j < 8; ++j) S[j] = 0.f;
        for (int m = 0; m < 16; ++m) {
            const size_t mb = (size_t)(bh * 16 + m) * 16384;
            v4u o; o.x = pkbf(S[0], S[1]); o.y = pkbf(S[2], S[3]); o.z = pkbf(S[4], S[5]); o.w = pkbf(S[6], S[7]);
            *(GAS v4u*)(ST + mb + (size_t)e * 128 + d0) = o;
#pragma unroll
            for (int j = 0; j < 8; ++j) S[j] = g256 * S[j] + g255 * U[mb + (size_t)(d0 + j) * 128 + e];
        }
#pragma unroll
        for (int j = 0; j < 8; ++j) Send[(size_t)bh * 16384 + (size_t)(d0 + j) * 128 + e] = S[j];
    } else {
        const int it = item - 1024, sh = it >> 5, wv = it & 31, e = (wv & 1) * 64 + lane, d0 = (wv >> 1) * 8;
        float S[8];
#pragma unroll
        for (int j = 0; j < 8; ++j) S[j] = S0s[(size_t)sh * 16384 + (size_t)(d0 + j) * 128 + e];
        v4u o; o.x = pkbf(S[0], S[1]); o.y = pkbf(S[2], S[3]); o.z = pkbf(S[4], S[5]); o.w = pkbf(S[6], S[7]);
        *(GAS v4u*)(STS + (size_t)sh * 16384 + (size_t)e * 128 + d0) = o;
    }
}
__device__ __forceinline__ void kv_issue(v4u (&kx)[8], v4u (&vx)[8], const bf16* Ks, const bf16* Vs, size_t pitch, int nk, int tid) {
    const int c = tid & 15, r0 = tid >> 4;
    if (nk == 256) {
#pragma unroll
        for (int i = 0; i < 8; ++i) { kx[i] = *(const GAS v4u*)(Ks + (size_t)(r0 + 32 * i) * pitch + 8 * c); vx[i] = *(const GAS v4u*)(Vs + (size_t)(r0 + 32 * i) * pitch + 8 * c); }
    } else { kx[0] = *(const GAS v4u*)(Ks + (size_t)r0 * pitch + 8 * c); vx[0] = *(const GAS v4u*)(Vs + (size_t)r0 * pitch + 8 * c); }
}
__device__ __forceinline__ void img_write(LAS unsigned char* img, const v4u (&x)[8], int nk, int tid) {
    const int c = tid & 15, r0 = tid >> 4;
    if (nk == 256) {
#pragma unroll
        for (int i = 0; i < 8; ++i) *(LAS v4u*)(img + (r0 + 32 * i) * RP + 16 * c) = x[i];
    } else *(LAS v4u*)(img + r0 * RP + 16 * c) = x[0];
}
__device__ __forceinline__ void retC_unit(LAS unsigned char* lds, const bf16* proj, bf16* mix, const bf16* STp, const float* g_ret, int row0, int nk, int h, int tid) {
    const int lane = tid & 63, w = __builtin_amdgcn_readfirstlane(tid >> 6), n_ = lane & 15, fq = lane >> 4, q_ = n_ >> 2, p_ = lane & 3;
    const bool act = nk == 256 || w == 0;
    const int qt0 = nk == 256 ? w : 0, qt1 = nk == 256 ? 15 - w : 1;
    const float gamma = 1.0f - exp2f(-5.0f - (float)h);
    __syncthreads();
    v4u kx[8], vx[8], sx[4];
    { const int c = tid & 15, r0 = tid >> 4;
#pragma unroll
      for (int i = 0; i < 4; ++i) sx[i] = *(const GAS v4u*)(STp + (size_t)(r0 + 32 * i) * 128 + 8 * c); }
    kv_issue(kx, vx, proj + (size_t)row0 * INW + C_RK + 128 * h, proj + (size_t)row0 * INW + C_RV + 128 * h, INW, nk, tid);
    const size_t tok0 = (size_t)(row0 + 16 * qt0 + n_), tok1 = (size_t)(row0 + 16 * qt1 + n_);
    bf16x8 qf0[4], qf1[4];
#pragma unroll
    for (int s = 0; s < 4; ++s) { qf0[s] = *(const GAS bf16x8*)(proj + tok0 * INW + C_RQ + 128 * h + 32 * s + 8 * fq); qf1[s] = *(const GAS bf16x8*)(proj + tok1 * INW + C_RQ + 128 * h + 32 * s + 8 * fq); }
    { const int c = tid & 15, r0 = tid >> 4;
#pragma unroll
      for (int i = 0; i < 4; ++i) *(LAS v4u*)(lds + R2_V + (r0 + 32 * i) * RP + 16 * c) = sx[i]; }
    img_write(lds, kx, nk, tid);
    __syncthreads();
    f32x4 ot0[8], ot1[8];
#pragma unroll
    for (int et = 0; et < 8; ++et) { f32x4 a0 = {0.f, 0.f, 0.f, 0.f}, a1 = {0.f, 0.f, 0.f, 0.f};
        if (act) {
#pragma unroll
            for (int s = 0; s < 4; ++s) { const bf16x8 sa = *(const LAS bf16x8*)(lds + R2_V + (16 * et + n_) * RP + (32 * s + 8 * fq) * 2); a0 = mfma16(sa, qf0[s], a0); a1 = mfma16(sa, qf1[s], a1); }
        }
        ot0[et] = a0 * gamma; ot1[et] = a1 * gamma; }
    __syncthreads();
    img_write(lds + R2_V, vx, nk, tid);
    __syncthreads();
    if (act) {
        const int np0 = (qt0 >> 1) + 1, np1 = (qt1 >> 1) + 1;
#pragma unroll 1
        for (int s2 = 0; s2 < np1; ++s2) {
            const int jt0 = 2 * s2, jt1 = jt0 + 1; const bool lo = s2 < np0;
            bf16x8 ka[4], kb[4];
#pragma unroll
            for (int s = 0; s < 4; ++s) { ka[s] = *(const LAS bf16x8*)(lds + (16 * jt0 + n_) * RP + (32 * s + 8 * fq) * 2); kb[s] = *(const LAS bf16x8*)(lds + (16 * jt1 + n_) * RP + (32 * s + 8 * fq) * 2); }
            f32x4 c0 = {0.f, 0.f, 0.f, 0.f}, c1 = c0, d0 = c0, d1 = c0;
#pragma unroll
            for (int s = 0; s < 4; ++s) { c0 = mfma16(ka[s], qf1[s], c0); if (jt1 <= qt1) c1 = mfma16(kb[s], qf1[s], c1); }
            if (lo) {
#pragma unroll
                for (int s = 0; s < 4; ++s) { d0 = mfma16(ka[s], qf0[s], d0); if (jt1 <= qt0) d1 = mfma16(kb[s], qf0[s], d1); }
            }
#pragma unroll
            for (int r = 0; r < 4; ++r) { const bool up = 4 * fq + r > n_;
                if (jt0 == qt1 && up) c0[r] = 0.f;
                if (jt1 == qt1 && up) c1[r] = 0.f;
                if (jt0 == qt0 && up) d0[r] = 0.f;
                if (jt1 == qt0 && up) d1[r] = 0.f; }
            const bf16x8 bp1 = pack8(c0, c1), bp0 = pack8(d0, d1);
#pragma unroll
            for (int et = 0; et < 8; ++et) { LAS unsigned char* vb = lds + R2_V + (32 * s2 + 4 * fq + q_) * RP + (16 * et + 4 * p_) * 2;
                const bf16x8 va = cat8(lds_tr(vb), lds_tr(vb + 16 * RP));
                ot1[et] = mfma16(va, bp1, ot1[et]); if (lo) ot0[et] = mfma16(va, bp0, ot0[et]); }
        }
#pragma unroll
        for (int k = 0; k < 2; ++k) {
            f32x4 (&ot)[8] = k == 0 ? ot0 : ot1; const size_t tokq = k == 0 ? tok0 : tok1;
            float sm = 0.f;
#pragma unroll
            for (int et = 0; et < 8; ++et) sm += (ot[et][0] + ot[et][1]) + (ot[et][2] + ot[et][3]);
            sm += __shfl_xor(sm, 16); sm += __shfl_xor(sm, 32);
            const float mean = sm * (1.f / 128.f); float sq = 0.f;
#pragma unroll
            for (int et = 0; et < 8; ++et) { ot[et] = ot[et] - mean; sq += (ot[et][0] * ot[et][0] + ot[et][1] * ot[et][1]) + (ot[et][2] * ot[et][2] + ot[et][3] * ot[et][3]); }
            sq += __shfl_xor(sq, 16); sq += __shfl_xor(sq, 32);
            const float rstd = 1.f / sqrtf(sq * (1.f / 128.f) + EPS);
#pragma unroll
            for (int et = 0; et < 8; ++et) { const int e0 = 128 * h + 16 * et + 4 * fq;
                const u32x2 gw_ = *(const GAS u32x2*)(proj + tokq * INW + C_RG + e0); const f32x4 gg = *(const GAS f32x4*)(g_ret + e0);
                u32x2 o; o.x = pkbf(ot[et][0] * rstd * gg[0] * silu_f(bflo(gw_.x)), ot[et][1] * rstd * gg[1] * silu_f(bfhi(gw_.x)));
                o.y = pkbf(ot[et][2] * rstd * gg[2] * silu_f(bflo(gw_.y)), ot[et][3] * rstd * gg[3] * silu_f(bfhi(gw_.y)));
                *(GAS u32x2*)(mix + tokq * MIXW + MX_RO + e0) = o; }
        }
    }
}

__device__ __forceinline__ void gmlp_unit(LAS unsigned char* lds, const bf16* proj, bf16* mix, const bf16* wtril, const float* b_s, const float* g_gmlp, float* gvs_out,
                                          int row0, int nrows, int tid) {
    const int lane = tid & 63, w = __builtin_amdgcn_readfirstlane(tid >> 6), n_ = lane & 15, fq = lane >> 4;
    LAS f32x2* st = (LAS f32x2*)lds;
    for (int rr = w; rr < nrows; rr += 8) {
        const v4u x = *(const GAS v4u*)(proj + (size_t)(row0 + rr) * INW + C_GV + 8 * lane);
        float f[8]; float s = 0.f;
#pragma unroll
        for (int e = 0; e < 8; ++e) { f[e] = bfel(x, e); s += f[e]; }
        const float mean = wave_sum(s) * (1.f / 512.f); float q = 0.f;
#pragma unroll
        for (int e = 0; e < 8; ++e) { f[e] -= mean; q += f[e] * f[e]; }
        const float rstd = 1.f / sqrtf(wave_sum(q) * (1.f / 512.f) + EPS);
        if (lane == 0) st[rr] = (f32x2){mean, rstd};
        if (gvs_out) { const f32x4 g0 = *(const GAS f32x4*)(g_gmlp + 8 * lane), g1 = *(const GAS f32x4*)(g_gmlp + 8 * lane + 4);
            f32x4 o0 = {f[0] * rstd * g0.x, f[1] * rstd * g0.y, f[2] * rstd * g0.z, f[3] * rstd * g0.w}, o1 = {f[4] * rstd * g1.x, f[5] * rstd * g1.y, f[6] * rstd * g1.z, f[7] * rstd * g1.w};
            *(GAS f32x4*)(gvs_out + (size_t)rr * 512 + 8 * lane) = o0; *(GAS f32x4*)(gvs_out + (size_t)rr * 512 + 8 * lane + 4) = o1; }
    }
    __syncthreads();
    const int mt = w;
    if (16 * mt < nrows) {
        const int smax = (16 * mt + 15) >> 5;
        for (int g = 0; g < 4; ++g) {
            f32x4 acc[8];
#pragma unroll
            for (int t = 0; t < 8; ++t) acc[t] = (f32x4){0.f, 0.f, 0.f, 0.f};
            const f32x4 ga = *(const GAS f32x4*)(g_gmlp + 128 * g + 8 * n_), gb = *(const GAS f32x4*)(g_gmlp + 128 * g + 8 * n_ + 4);
            const float gn[8] = {ga.x, ga.y, ga.z, ga.w, gb.x, gb.y, gb.z, gb.w};
            for (int s = 0; s <= smax; ++s) {
                const bf16x8 a = *(const GAS bf16x8*)(wtril + (size_t)(g * 128 + 16 * mt + n_) * 128 + 32 * s + 8 * fq);
                unsigned fw[8][4];
#pragma unroll
                for (int jp = 0; jp < 4; ++jp) {
                    const int j0 = 32 * s + 8 * fq + 2 * jp;
                    const v4u xa = *(const GAS v4u*)(proj + (size_t)(row0 + j0) * INW + C_GV + 128 * g + 8 * n_), xb = *(const GAS v4u*)(proj + (size_t)(row0 + j0 + 1) * INW + C_GV + 128 * g + 8 * n_);
                    const f32x2 sa = st[j0], sb = st[j0 + 1];
#pragma unroll
                    for (int t = 0; t < 8; ++t) fw[t][jp] = pkbf((bfel(xa, t) - sa.x) * sa.y * gn[t], (bfel(xb, t) - sb.x) * sb.y * gn[t]);
                }
#pragma unroll
                for (int t = 0; t < 8; ++t) { v4u fr_; fr_.x = fw[t][0]; fr_.y = fw[t][1]; fr_.z = fw[t][2]; fr_.w = fw[t][3]; acc[t] = mfma16(a, __builtin_bit_cast(bf16x8, fr_), acc[t]); }
            }
#pragma unroll
            for (int r = 0; r < 4; ++r) { const int i = 16 * mt + 4 * fq + r; const size_t tok = (size_t)(row0 + i); const float bias = b_s[g * 128 + i];
                const v4u gu = *(const GAS v4u*)(proj + tok * INW + C_GU + 128 * g + 8 * n_), gg = *(const GAS v4u*)(proj + tok * INW + C_GG + 128 * g + 8 * n_);
                float o[8];
#pragma unroll
                for (int t = 0; t < 8; ++t) o[t] = bfel(gu, t) * (acc[t][r] + bias) * silu_f(bfel(gg, t));
                v4u ow; ow.x = pkbf(o[0], o[1]); ow.y = pkbf(o[2], o[3]); ow.z = pkbf(o[4], o[5]); ow.w = pkbf(o[6], o[7]);
                *(GAS v4u*)(mix + tok * MIXW + MX_GO + 128 * g + 8 * n_) = ow; }
        }
    }
}

__device__ __forceinline__ void attn_unit(LAS unsigned char* lds, const bf16* proj, bf16* mix, const bf16* Kp, const bf16* Vp, int pitch, int tokbase, int nqt, int h, int tid) {
    const int lane = tid & 63, w = __builtin_amdgcn_readfirstlane(tid >> 6), n_ = lane & 15, fq = lane >> 4, q_ = n_ >> 2, p_ = lane & 3;
    __syncthreads();
    { v4u kx[8], vx[8]; kv_issue(kx, vx, Kp, Vp, (size_t)pitch, 256, tid); img_write(lds, kx, 256, tid); img_write(lds + R2_V, vx, 256, tid); }
    __syncthreads();
    if (w * nqt * 16 >= (nqt == 2 ? 256 : 32)) return;
#pragma unroll 1
    for (int k = 0; k < nqt; ++k) {
        const size_t tokq = (size_t)(tokbase + 16 * (w * nqt + k) + n_);
        const bf16* qrow = proj + tokq * INW;
        bf16x8 qf[4];
#pragma unroll
        for (int s = 0; s < 4; ++s) qf[s] = *(const GAS bf16x8*)(qrow + C_AQ + 128 * h + 32 * s + 8 * fq);
        u32x2 ag[8];
#pragma unroll
        for (int et = 0; et < 8; ++et) ag[et] = *(const GAS u32x2*)(qrow + C_AG + 128 * h + 16 * et + 4 * fq);
        f32x4 sc[16];
#pragma unroll
        for (int mt = 0; mt < 16; ++mt) { f32x4 a = {0.f, 0.f, 0.f, 0.f};
#pragma unroll
            for (int s = 0; s < 4; ++s) { const bf16x8 ka = *(const LAS bf16x8*)(lds + (16 * mt + n_) * RP + (32 * s + 8 * fq) * 2); a = mfma16(ka, qf[s], a); }
            sc[mt] = a; }
        float mx = sc[0][0];
#pragma unroll
        for (int mt = 0; mt < 16; ++mt)
#pragma unroll
            for (int r = 0; r < 4; ++r) mx = fmaxf(mx, sc[mt][r]);
        mx = fmaxf(mx, __shfl_xor(mx, 16)); mx = fmaxf(mx, __shfl_xor(mx, 32));
        const float c2 = 0.08838834764831845f * 1.4426950408889634f; float l = 0.f;
#pragma unroll
        for (int mt = 0; mt < 16; ++mt)
#pragma unroll
            for (int r = 0; r < 4; ++r) { const float p = __builtin_amdgcn_exp2f((sc[mt][r] - mx) * c2); sc[mt][r] = p; l += p; }
        l += __shfl_xor(l, 16); l += __shfl_xor(l, 32);
        f32x4 ot[8];
#pragma unroll
        for (int et = 0; et < 8; ++et) ot[et] = (f32x4){0.f, 0.f, 0.f, 0.f};
#pragma unroll
        for (int s2 = 0; s2 < 8; ++s2) {
            const bf16x8 bp = pack8(sc[2 * s2], sc[2 * s2 + 1]);
#pragma unroll
            for (int et = 0; et < 8; ++et) { LAS unsigned char* vb = lds + R2_V + (32 * s2 + 4 * fq + q_) * RP + (16 * et + 4 * p_) * 2;
                ot[et] = mfma16(cat8(lds_tr(vb), lds_tr(vb + 16 * RP)), bp, ot[et]); }
            __builtin_amdgcn_sched_barrier(0);
        }
        const float inv = 1.f / l;
#pragma unroll
        for (int et = 0; et < 8; ++et) {
            u32x2 o; o.x = pkbf(ot[et][0] * inv * silu_f(bflo(ag[et].x)), ot[et][1] * inv * silu_f(bfhi(ag[et].x)));
            o.y = pkbf(ot[et][2] * inv * silu_f(bflo(ag[et].y)), ot[et][3] * inv * silu_f(bfhi(ag[et].y)));
            *(GAS u32x2*)(mix + tokq * MIXW + MX_AO + 128 * h + 16 * et + 4 * fq) = o; }
    }
}

constexpr int NU1 = 144 + 512 + 128, NU2 = (1024 + 4096) / 8, NU3 = 512 + 128, N_ATT_UNITS = 256 + 64;
struct Args { const float* in[16]; float* out; unsigned char* ws; };
#ifndef REP_ATT
#define REP_ATT 1
#endif
#ifndef REP_GM
#define REP_GM 1
#endif
#ifndef REP_RA
#define REP_RA 1
#endif
#ifndef REP_RB
#define REP_RB 1
#endif
#ifndef REP_RC
#define REP_RC 1
#endif
#ifndef REP_P0
#define REP_P0 1
#endif
#ifndef REP_P1
#define REP_P1 1
#endif
#ifndef REP_P2
#define REP_P2 1
#endif
#ifndef REP_P3
#define REP_P3 1
#endif

__global__ void __launch_bounds__(NWAVES * 64, 2) fwd_megakernel(Args args) {
    extern __shared__ __attribute__((aligned(16))) unsigned char lds_raw[];
    LAS unsigned char* lds = (LAS unsigned char*)lds_raw;
    volatile LAS unsigned* MISC = (volatile LAS unsigned*)(lds + MISC_OFF);
    const int tid0 = threadIdx.x, wave = __builtin_amdgcn_readfirstlane(tid0 >> 6);
    const int G = gridDim.x, bx = blockIdx.x, vcu = (G % 8 == 0) ? (bx % 8) * (G / 8) + bx / 8 : bx;
    const int gw = vcu * NWAVES + wave, NGW = G * NWAVES;
    Ptrs P;
    P.x_prompt = args.in[0]; P.x_sample = args.in[1]; P.mem_prompt = args.in[2]; P.state_ret = args.in[3]; P.cache_k = args.in[4]; P.cache_v = args.in[5];
    P.g_norm = args.in[6]; P.w_in = args.in[7]; P.g_ret = args.in[8]; P.g_gmlp = args.in[9]; P.w_s = args.in[10]; P.b_s = args.in[11]; P.g_mem = args.in[12];
    P.w_mem_kv = args.in[13]; P.w_out = args.in[14]; P.g_final = args.in[15]; P.out = args.out; P.ws = args.ws;
    gu32* ctl = (gu32*)(P.ws + WS_CTL);
    bf16* const WINT = (bf16*)(P.ws + WS_WINT); bf16* const WOUTT = (bf16*)(P.ws + WS_WOUTT); bf16* const XN = (bf16*)(P.ws + WS_XN);
    bf16* const PROJ = (bf16*)(P.ws + WS_PROJ); bf16* const MIX = (bf16*)(P.ws + WS_MIX); bf16* const MKV = (bf16*)(P.ws + WS_MKV);
    bf16* const CK = (bf16*)(P.ws + WS_CK); bf16* const CV = (bf16*)(P.ws + WS_CV);
    float* const UBUF = (float*)(P.ws + WS_U); bf16* const STB = (bf16*)(P.ws + WS_ST); bf16* const STSB = (bf16*)(P.ws + WS_STS);
    const float* const ROPE = (const float*)(P.ws + WS_ROPE); float* const SSQ = (float*)(P.ws + WS_SSQ); const bf16* const WTRIL = (const bf16*)(P.ws + WS_WTRIL);

    for (int u = tid0; u < (LDS_BYTES - LDSCTL_OFF) / 4; u += NWAVES * 64) ((LAS unsigned*)(lds + LDSCTL_OFF))[u] = 0u;
    __syncthreads();
    XcdBarrier bar = xcd_barrier_post((unsigned*)(ctl + CW_BAR), MISC + 8);

#ifndef SKIP_P0
    for (int rep = 0; rep < REP_P0; ++rep) { int l0 = tid0 & 63; asm volatile("" : "+v"(l0)); p0_prologue(P, lds, gw, NGW, wave, l0); }
#endif
    xcd_barrier(bar);

#ifndef SKIP_P1
    for (int rep = 0; rep < REP_P1; ++rep) {
        pg8::Gemm g{XN, WINT, MTOK + NMEM, INW + KVW, DM}; pg8::Order1 S; S.init(G, bx);
        pg8::EpiProj E{PROJ, P.out + O_MK, P.out + O_MV, MKV, ROPE};
        pg8::gemm_phase<pg8::EpiProj, pg8::Order1, true, true>(lds, g, S, E);
    }
#endif
    xcd_barrier(bar);

    static_assert(R2_END <= LDSCTL_OFF, "retention LDS");
    for (int rep = 0; rep < REP_P2; ++rep)
#pragma unroll 1
    for (int ph = 0; ph < 3; ++ph) {
        const int NU = ph == 0 ? NU1 : (ph == 1 ? NU2 : NU3);
        gu32* qh = ctl + (ph == 0 ? CW_Q1 : (ph == 1 ? CW_Q2 : CW_Q3)) + 512 * rep; gu32* dn = ctl + (ph == 0 ? CW_D1 : CW_D2) + 512 * rep; gu32* ah = ctl + CW_ATT + 512 * rep;
        bool prev_phase_unit = false;
#pragma unroll 1
        for (;;) {
            __syncthreads();
            if (tid0 == 0) {
                if (prev_phase_unit) __hip_atomic_fetch_add(dn, 1u, RLX_AGENT);
                int code; const unsigned u = __hip_atomic_fetch_add(qh, 1u, RLX_AGENT);
                if (u < (unsigned)NU) code = (int)u;
                else if (ph < 2 && __hip_atomic_load(dn, RLX_AGENT) >= (unsigned)NU) code = -1;
                else { const unsigned a = __hip_atomic_fetch_add(ah, 1u, RLX_AGENT); code = a < (unsigned)(REP_ATT * N_ATT_UNITS) ? NU + (int)(a % (unsigned)N_ATT_UNITS) : -1; }
                MISC[0] = (unsigned)code;
            }
            __syncthreads();
            const int u = (int)MISC[0];
            if (u < 0) break;
            prev_phase_unit = u < NU;
            int tid = threadIdx.x; asm volatile("" : "+v"(tid)); const int lane = tid & 63;
            if (u >= NU) { const int a = u - NU; const bool smp = a >= 256; const int a2 = a - 256, sb = smp ? a2 >> 2 : a >> 6, h = smp ? a2 & 3 : (a >> 4) & 3, qc = a & 15;
                const bf16* Kp = smp ? CK + (size_t)sb * MEMLEN * 512 + 128 * h : MKV + (size_t)sb * MEMLEN * 1024 + 128 * h;
                const bf16* Vp = smp ? CV + (size_t)sb * MEMLEN * 512 + 128 * h : MKV + (size_t)sb * MEMLEN * 1024 + 512 + 128 * h;
#ifndef NO_ATT
                attn_unit(lds, PROJ, MIX, Kp, Vp, smp ? 512 : 1024, smp ? TP + sb * DECL : sb * SEQ + qc * 256, smp ? 1 : 2, h, tid);
#endif
            } else if (ph == 0) {
                if (u < 144) { const bool smp = u >= 128; const int c = smp ? u - 128 : u;
                    for (int rr = 0; rr < REP_GM; ++rr) gmlp_unit(lds, PROJ, MIX, WTRIL, P.b_s, P.g_gmlp, smp ? P.out + O_GVS + (size_t)c * DECL * 512 : nullptr, smp ? TP + c * DECL : c * 128, smp ? DECL : 128, tid);
                } else { const int v = u - 144; const bool smp = v >= 512; const int sh = v - 512, bh = v >> 4, m = v & 15, h = smp ? sh & 7 : bh & 7;
                    for (int rr = 0; rr < REP_RA; ++rr) retA_unit(lds, PROJ, smp ? TP + (sh >> 3) * DECL : (bh >> 3) * SEQ + m * 256, smp ? DECL : 256, h, smp ? P.state_ret + (size_t)sh * 16384 : nullptr,
                              smp ? P.out + O_SRS + (size_t)sh * 16384 : UBUF + (size_t)v * 16384, tid); }
            } else if (ph == 1) {
                for (int rr = 0; rr < REP_RB; ++rr) retB_item(UBUF, STB, P.state_ret, STSB, P.out + O_SRP, u * 8 + wave, lane);
            } else { const bool smp = u >= 512; const int sh = u - 512, bh = u >> 4, m = u & 15, h = smp ? sh & 7 : bh & 7;
#ifndef NO_RC
                for (int rr = 0; rr < REP_RC; ++rr) retC_unit(lds, PROJ, MIX, smp ? STSB + (size_t)sh * 16384 : STB + (size_t)u * 16384, P.g_ret, smp ? TP + (sh >> 3) * DECL : (bh >> 3) * SEQ + m * 256, smp ? DECL : 256, h, tid);
#endif
            }
        }
        xcd_barrier(bar);
    }

#ifndef SKIP_P3
    for (int rep = 0; rep < REP_P3; ++rep) {
        pg8::Gemm g{MIX, WOUTT, MTOK, DM, DM}; pg8::StaticOrder S; S.init(MTOK, DM, G, bx);
        pg8::EpiOut E{P.x_prompt, P.x_sample, P.out + O_Y, SSQ};
        pg8::gemm_phase<pg8::EpiOut, pg8::StaticOrder, true, true>(lds, g, S, E);
    }
#endif
    xcd_barrier(bar);

    int lane4 = tid0 & 63; asm volatile("" : "+v"(lane4));
    for (int row = gw; row < MTOK; row += NGW) { const int lane = lane4;
        const float p = lane < 32 ? SSQ[(size_t)row * 32 + lane] : 0.f;
        const float rstd = 1.f / sqrtf(wave_sum(p) * (1.f / DM) + EPS);
        GAS f32x4* o = (GAS f32x4*)(P.out + O_Y + (size_t)row * DM) + lane; const GAS f32x4* gf = (const GAS f32x4*)P.g_final + lane;
#pragma unroll
        for (int j = 0; j < 8; ++j) { const f32x4 v = o[64 * j], gg = gf[64 * j]; o[64 * j] = v * rstd * gg; }
    }
}

extern "C" void kernel_launch(void* const* d_in, const int* in_sizes, int n_in, void* d_out, int out_size, void* d_ws, size_t ws_size, hipStream_t stream) {
    static int grid = 0;
    if (grid == 0) {
        if (n_in != 16 || in_sizes[0] != TP * DM || (size_t)out_size != O_END || ws_size < WS_END) {
            fprintf(stderr, "kernel_launch: unexpected shapes (n_in %d in0 %d out %d ws %zu); nothing launched\n", n_in, n_in > 0 ? in_sizes[0] : -1, out_size, ws_size); grid = -1; return; }
        int dev = 0, cus = 0, per_cu = 0;
        if (hipGetDevice(&dev) != hipSuccess || hipDeviceGetAttribute(&cus, hipDeviceAttributeMultiprocessorCount, dev) != hipSuccess) { fprintf(stderr, "kernel_launch: device query failed\n"); grid = -1; return; }
        if (hipFuncSetAttribute((const void*)fwd_megakernel, hipFuncAttributeMaxDynamicSharedMemorySize, LDS_BYTES) != hipSuccess) { fprintf(stderr, "kernel_launch: hipFuncSetAttribute failed\n"); grid = -1; return; }
        if (hipOccupancyMaxActiveBlocksPerMultiprocessor(&per_cu, (const void*)fwd_megakernel, NWAVES * 64, LDS_BYTES) != hipSuccess || per_cu < 1) {
            fprintf(stderr, "kernel_launch: occupancy query reports %d workgroups per CU\n", per_cu); (void)hipGetLastError(); per_cu = 1; }
        grid = cus;
    }
    if (grid < 0) return;
    if (hipMemsetAsync((char*)d_ws + WS_CTL, 0, CTL_ZERO_BYTES, stream) != hipSuccess) { fprintf(stderr, "kernel_launch: memset failed\n"); return; }
    Args a{};
    for (int i = 0; i < 16; ++i) a.in[i] = (const float*)d_in[i];
    a.out = (float*)d_out; a.ws = (unsigned char*)d_ws;
    hipLaunchKernelGGL(fwd_megakernel, dim3(grid), dim3(NWAVES * 64), LDS_BYTES, stream, a);
    const hipError_t le = hipPeekAtLastError();
    if (le != hipSuccess) fprintf(stderr, "kernel_launch: launch failed: %s\n", hipGetErrorName(le));
}
```
